# Optimizing an MI355X kernel written in HIP

```python
import jax, jax.numpy as jnp
from jax import lax
import numpy as np

D_MODEL = 1024
BATCH = 2
SEQ = 8192
DEPTH = 2

N_A_LAYERS = DEPTH // 2
N_B_LAYERS = DEPTH - N_A_LAYERS

EPS = 1e-6
PLE_DIM = 256
D_FF = ((8 * D_MODEL // 3 + 255) // 256) * 256

A_KEY_DIM = 128
A_HEADS = D_MODEL // A_KEY_DIM
A_VAL_DIM = D_MODEL // A_HEADS
A_WIDTH = A_HEADS * A_KEY_DIM
A_CHUNK = 64

B_HEADS = 16
B_NOPE = 128
B_ROPE = 64
B_VDIM = 128
B_Q_LORA = 512
B_KV_LORA = 256
Q_BLOCK = 128
ROPE_THETA = 10000.0

kernel_name = 'yoco_hgrn2_mla_macaron_ple'


def _rmsnorm(x, g):
    x32 = x.astype(jnp.float32)
    y = x32 * lax.rsqrt(jnp.mean(x32 * x32, axis=-1, keepdims=True) + EPS)
    return (y * g.astype(jnp.float32)).astype(x.dtype)


def _swiglu(h, w_in, w_out):
    gate, up = jnp.split(h @ w_in, 2, axis=-1)
    return (jax.nn.silu(gate) * up) @ w_out


def _rope(x, positions):
    d = x.shape[-1]
    inv_freq = 1.0 / (ROPE_THETA ** (jnp.arange(0, d, 2, dtype=jnp.float32) / d))
    ang = positions.astype(jnp.float32)[..., None] * inv_freq
    ang = ang.reshape(ang.shape[:2] + (1,) * (x.ndim - 3) + (d // 2,))
    cos, sin = jnp.cos(ang), jnp.sin(ang)
    x32 = x.astype(jnp.float32)
    x1, x2 = x32[..., : d // 2], x32[..., d // 2:]
    return jnp.concatenate([x1 * cos - x2 * sin, x2 * cos + x1 * sin], axis=-1).astype(x.dtype)


def _hgrn2_chunk(state, inp):
    q, k, v, g = inp
    b = jnp.cumsum(g, axis=2)
    o_inter = jnp.einsum('bhtk,bhkv->bhtv', q * jnp.exp(b), state)
    causal = jnp.tril(jnp.ones((A_CHUNK, A_CHUNK), dtype=bool))[:, :, None]
    diff = b[:, :, :, None, :] - b[:, :, None, :, :]
    decay = jnp.where(causal, jnp.exp(jnp.where(causal, diff, 0.0)), 0.0)
    scores = jnp.einsum('bhtk,bhsk,bhtsk->bhts', q, k, decay)
    o_intra = jnp.einsum('bhts,bhsv->bhtv', scores, v)
    b_last = b[:, :, -1:, :]
    new_state = jnp.exp(b_last[:, :, 0, :])[..., None] * state + jnp.einsum(
        'bhsk,bhsv->bhkv', k * jnp.exp(b_last - b), v)
    return new_state, o_inter + o_intra


def _hgrn2_mixer(h, w_in, lb, out_gain, w_out):
    bsz, seq, _ = h.shape
    q, f_logit, i, g = jnp.split(h @ w_in, 4, axis=-1)
    f_logit = f_logit.astype(jnp.float32)
    lb = lb.astype(jnp.float32)
    log_f = jnp.log(lb + (1.0 - lb) * jax.nn.sigmoid(f_logit))
    k = (1.0 - lb) * jax.nn.sigmoid(-f_logit)
    n_chunks = seq // A_CHUNK

    def to_chunks(t, d):
        t = t.astype(jnp.float32).reshape(bsz, n_chunks, A_CHUNK, A_HEADS, d)
        return t.transpose(1, 0, 3, 2, 4)

    qc = to_chunks(q, A_KEY_DIM) * (A_KEY_DIM ** -0.5)
    kc = to_chunks(k, A_KEY_DIM)
    vc = to_chunks(i, A_VAL_DIM)
    gc = to_chunks(log_f, A_KEY_DIM)
    s0 = jnp.zeros((bsz, A_HEADS, A_KEY_DIM, A_VAL_DIM), jnp.float32)
    _, o = lax.scan(_hgrn2_chunk, s0, (qc, kc, vc, gc))
    o = o.transpose(1, 0, 3, 2, 4).reshape(bsz, seq, A_HEADS, A_VAL_DIM)
    o = _rmsnorm(o, out_gain).reshape(bsz, seq, A_HEADS * A_VAL_DIM)
    o = o * jax.nn.sigmoid(g.astype(jnp.float32))
    return o.astype(h.dtype) @ w_out


def _mla_shared_kv(x, positions, norm_in, w_down, latent_norm, w_up):
    bsz, seq, _ = x.shape
    h = _rmsnorm(x, norm_in)
    c_kv, k_r = jnp.split(h @ w_down, [B_KV_LORA], axis=-1)
    c_kv = _rmsnorm(c_kv, latent_norm)
    kv = (c_kv @ w_up).reshape(bsz, seq, B_HEADS, B_NOPE + B_VDIM)
    k_nope, v = jnp.split(kv, [B_NOPE], axis=-1)
    k_rope = _rope(k_r, positions)
    return k_nope, k_rope, v


def _mla_mixer(h, positions, k_nope, k_rope, v, w_dq, q_norm, w_uq, w_out):
    bsz, seq, _ = h.shape
    c_q = _rmsnorm(h @ w_dq, q_norm)
    q = (c_q @ w_uq).reshape(bsz, seq, B_HEADS, B_NOPE + B_ROPE)
    q_nope, q_rope = jnp.split(q, [B_NOPE], axis=-1)
    q_rope = _rope(q_rope, positions)
    n_blocks = seq // Q_BLOCK
    scale = (B_NOPE + B_ROPE) ** -0.5

    def blocks(t):
        return t.reshape((bsz, n_blocks, Q_BLOCK) + t.shape[2:]).swapaxes(0, 1)

    key_idx = jnp.arange(seq)

    def attend(args):
        qn, qr, blk = args
        s = (jnp.einsum('bqhd,bkhd->bhqk', qn, k_nope)
             + jnp.einsum('bqhd,bkd->bhqk', qr, k_rope)).astype(jnp.float32) * scale
        q_idx = blk * Q_BLOCK + jnp.arange(Q_BLOCK)
        mask = q_idx[:, None] >= key_idx[None, :]
        s = jnp.where(mask[None, None], s, -jnp.inf)
        pr = jax.nn.softmax(s, axis=-1).astype(v.dtype)
        return jnp.einsum('bhqk,bkhd->bqhd', pr, v)

    o = lax.map(attend, (blocks(q_nope), blocks(q_rope), jnp.arange(n_blocks, dtype=jnp.int32)))
    o = o.swapaxes(0, 1).reshape(bsz, seq, B_HEADS * B_VDIM)
    return o @ w_out


def setup_inputs(seed: int = 0) -> dict:
    key = jax.random.key(seed)
    ks = jax.random.split(key, 24)
    f32 = jnp.float32

    def w(k, shape, fan_in):
        return jax.random.normal(k, shape, f32) * (fan_in ** -0.5)

    def gain(k, shape):
        return 1.0 + 0.02 * jax.random.normal(k, shape, f32)

    offset = jax.random.randint(ks[2], (BATCH, 1), 0, 1024, dtype=jnp.int32)
    positions = offset + jnp.arange(SEQ, dtype=jnp.int32)[None, :]
    return {
        'x': jax.random.normal(ks[0], (BATCH, SEQ, D_MODEL), f32),
        'p': jax.random.normal(ks[1], (DEPTH, BATCH, SEQ, PLE_DIM), f32),
        'positions': positions,
        'norm_gains': gain(ks[3], (DEPTH, 4, D_MODEL)),
        'ffn_w_in': w(ks[4], (DEPTH, 2, D_MODEL, 2 * D_FF), D_MODEL),
        'ffn_w_out': w(ks[5], (DEPTH, 2, D_FF, D_MODEL), D_FF),
        'ple_w_gate': w(ks[6], (DEPTH, D_MODEL, D_MODEL), D_MODEL),
        'ple_w_in': w(ks[7], (DEPTH, PLE_DIM, D_MODEL), PLE_DIM),
        'a_w_in': w(ks[8], (N_A_LAYERS, D_MODEL, 4 * A_WIDTH), D_MODEL),
        'a_lb_logits': 0.1 * jax.random.normal(ks[9], (N_A_LAYERS + 1, A_WIDTH), f32),
        'a_out_gain': gain(ks[10], (N_A_LAYERS, A_VAL_DIM)),
        'a_w_out': w(ks[11], (N_A_LAYERS, A_WIDTH, D_MODEL), A_WIDTH),
        'kv_norm_in': gain(ks[12], (D_MODEL,)),
        'kv_w_down': w(ks[13], (D_MODEL, B_KV_LORA + B_ROPE), D_MODEL),
        'kv_latent_norm': gain(ks[14], (B_KV_LORA,)),
        'kv_w_up': w(ks[15], (B_KV_LORA, B_HEADS * (B_NOPE + B_VDIM)), B_KV_LORA),
        'b_w_dq': w(ks[16], (N_B_LAYERS, D_MODEL, B_Q_LORA), D_MODEL),
        'b_q_norm': gain(ks[17], (N_B_LAYERS, B_Q_LORA)),
        'b_w_uq': w(ks[18], (N_B_LAYERS, B_Q_LORA, B_HEADS * (B_NOPE + B_ROPE)), B_Q_LORA),
        'b_w_out': w(ks[19], (N_B_LAYERS, B_HEADS * B_VDIM, D_MODEL), B_HEADS * B_VDIM),
        'final_norm': gain(ks[20], (D_MODEL,)),
    }


def reference(x, p, positions, norm_gains, ffn_w_in, ffn_w_out, ple_w_gate, ple_w_in,
              a_w_in, a_lb_logits, a_out_gain, a_w_out,
              kv_norm_in, kv_w_down, kv_latent_norm, kv_w_up,
              b_w_dq, b_q_norm, b_w_uq, b_w_out, final_norm):
    lower_bounds = jnp.cumsum(jax.nn.softmax(a_lb_logits.astype(jnp.float32), axis=0), axis=0)
    shared = None
    if N_A_LAYERS == 0:
        shared = _mla_shared_kv(x, positions, kv_norm_in, kv_w_down, kv_latent_norm, kv_w_up)
    for li in range(DEPTH):
        g = norm_gains[li]
        x = x + 0.5 * _swiglu(_rmsnorm(x, g[0]), ffn_w_in[li, 0], ffn_w_out[li, 0])
        h = _rmsnorm(x, g[1])
        if li < N_A_LAYERS:
            x = x + _hgrn2_mixer(h, a_w_in[li], lower_bounds[li], a_out_gain[li], a_w_out[li])
        else:
            bi = li - N_A_LAYERS
            k_nope, k_rope, v = shared
            x = x + _mla_mixer(h, positions, k_nope, k_rope, v,
                               b_w_dq[bi], b_q_norm[bi], b_w_uq[bi], b_w_out[bi])
        x = x + 0.5 * _swiglu(_rmsnorm(x, g[2]), ffn_w_in[li, 1], ffn_w_out[li, 1])
        gate = jax.nn.sigmoid((_rmsnorm(x, g[3]) @ ple_w_gate[li]).astype(jnp.float32))
        x = x + (gate * (p[li] @ ple_w_in[li]).astype(jnp.float32)).astype(x.dtype)
        if li == N_A_LAYERS - 1:
            shared = _mla_shared_kv(x, positions, kv_norm_in, kv_w_down, kv_latent_norm, kv_w_up)
    return _rmsnorm(x, final_norm)
```

```cpp
#include <hip/hip_runtime.h>
#include <hip/hip_cooperative_groups.h>
#include <cstdio>
#include <cstdint>
#include <cmath>
namespace cg = cooperative_groups;

#define LAS __attribute__((address_space(3)))
typedef unsigned short bf16_t;
typedef short bf16x8 __attribute__((ext_vector_type(8)));
typedef short s16x4 __attribute__((ext_vector_type(4)));
typedef float f32x4 __attribute__((ext_vector_type(4)));
typedef float f32x2 __attribute__((ext_vector_type(2)));
typedef float f32x16 __attribute__((ext_vector_type(16)));
typedef unsigned u32x4 __attribute__((ext_vector_type(4)));
typedef unsigned u32x2 __attribute__((ext_vector_type(2)));

constexpr int T_ = 16384, S_ = 8192, D_ = 1024, FF_ = 2816;
constexpr float EPS_ = 1e-6f;
constexpr int LDS_BYTES = 147456;

constexpr size_t MiB = 1u << 20;
constexpr size_t SZ_FI = 5632ull * 1024 * 2, SZ_FO = 1024ull * 2816 * 2;
constexpr size_t OFF_FI = 0;
constexpr size_t OFF_FO = OFF_FI + 4 * SZ_FI;
constexpr size_t OFF_PG = OFF_FO + 4 * SZ_FO;
constexpr size_t OFF_PI = OFF_PG + 4 * MiB;
constexpr size_t OFF_AIN = OFF_PI + 1 * MiB;
constexpr size_t OFF_AOUT = OFF_AIN + 8 * MiB;
constexpr size_t OFF_KVD = OFF_AOUT + 2 * MiB;
constexpr size_t OFF_KVU = OFF_KVD + 1 * MiB;
constexpr size_t OFF_DQ = OFF_KVU + 2 * MiB;
constexpr size_t OFF_UQ = OFF_DQ + 1 * MiB;
constexpr size_t OFF_BO = OFF_UQ + 3 * MiB;
constexpr size_t OFF_SSQ0 = OFF_BO + 4 * MiB;
constexpr size_t OFF_SSQ1 = OFF_SSQ0 + 1 * MiB;
constexpr size_t OFF_SSQCKV = OFF_SSQ1 + 1 * MiB;
constexpr size_t OFF_SSQCQ = OFF_SSQCKV + MiB / 2;
constexpr size_t OFF_DEC = OFF_SSQCQ + MiB / 2;
constexpr size_t OFF_LB = OFF_DEC + 1 * MiB;
constexpr size_t OFF_ROPE = OFF_LB + 1 * MiB;
constexpr size_t OFF_PB = OFF_ROPE + 4 * MiB;
constexpr size_t OFF_XB = OFF_PB + 16 * MiB;
constexpr size_t OFF_POOL = OFF_XB + 32 * MiB;
constexpr size_t OFF_ACT = OFF_POOL;
constexpr size_t OFF_HQ = OFF_POOL;
constexpr size_t OFF_HV = OFF_POOL + 32 * MiB;
constexpr size_t OFF_HOG = OFF_POOL + 64 * MiB;
constexpr size_t OFF_HKK = OFF_POOL + 96 * MiB;
constexpr size_t OFF_HKN = OFF_POOL + 160 * MiB;
constexpr size_t OFF_PE = OFF_POOL + 96 * MiB;
constexpr size_t OFF_KNOPE = OFF_POOL;
constexpr size_t OFF_VT = OFF_POOL + 64 * MiB;
constexpr size_t OFF_QNOPE = OFF_POOL + 128 * MiB;
constexpr size_t OFF_CKV = OFF_POOL + 128 * MiB;
constexpr size_t OFF_XB2 = OFF_POOL + 160 * MiB;
constexpr size_t OFF_CQ = OFF_FI;
constexpr size_t OFF_KROPE = OFF_FI + 16 * MiB;
constexpr size_t WS_NEED = OFF_POOL + 192 * MiB;

struct KP { const float* in[21]; float* out; unsigned char* ws; float inv_freq[32]; };

__device__ __forceinline__ int tid_opaque() { int t = threadIdx.x; asm volatile("" : "+v"(t)); return t; }
typedef __bf16 bf16x2_t __attribute__((ext_vector_type(2)));
__device__ __forceinline__ unsigned cvt_pk_bf16(float lo, float hi) { const f32x2 v = {lo, hi}; const bf16x2_t b = __builtin_convertvector(v, bf16x2_t); return __builtin_bit_cast(unsigned, b); }
__device__ __forceinline__ float bf2f(unsigned short b) { return __uint_as_float(((unsigned)b) << 16); }
__device__ __forceinline__ float bflo(unsigned w) { return __uint_as_float(w << 16); }
__device__ __forceinline__ float bfhi(unsigned w) { return __uint_as_float(w & 0xffff0000u); }
__device__ __forceinline__ float frcp(float x) { return __builtin_amdgcn_rcpf(x); }
__device__ __forceinline__ float sigmoidf_(float x) { return frcp(1.0f + __expf(-x)); }
__device__ __forceinline__ u32x4 pack8(f32x4 a, f32x4 b) { u32x4 w; w.x = cvt_pk_bf16(a[0], a[1]); w.y = cvt_pk_bf16(a[2], a[3]); w.z = cvt_pk_bf16(b[0], b[1]); w.w = cvt_pk_bf16(b[2], b[3]); return w; }

constexpr int BM = 256, BK = 64, HALF = 128, HTB = HALF * BK * 2, STAGE_BYTES = 8 * HTB, NXCD = 8, WGM = 8;
__host__ __device__ __forceinline__ int lds_byte(int r, int c) { const int st = (r >> 4) * 2 + (c >> 5), rr = r & 15, cc = c & 31, ob = rr * 64 + cc * 2; return st * 1024 + (ob ^ (((ob >> 9) & 1) << 5)); }
__host__ __device__ __forceinline__ void stage_rc(int b, int& R, int& C) { const int st = b / 1024, sb = b % 1024, swz = sb ^ (((sb >> 9) & 1) << 5); R = (st >> 1) * 16 + swz / 64; C = (st & 1) * 32 + (swz % 64) / 2; }
__host__ __device__ __forceinline__ int perm32(int rho) { const int n = rho >> 4, i = rho & 15; return 8 * (i >> 2) + 4 * n + (i & 3); }

struct Unit { int pm, pn; };
enum { EPI_SWIGLU = 0, EPI_RESID = 1, EPI_PLE = 2, EPI_HGRN = 3, EPI_BF16 = 4, EPI_KVDOWN = 5, EPI_CQ = 6, EPI_KVUP = 7, EPI_QUP = 8 };
struct GemmJob {
    const bf16_t* A; const bf16_t* Bt; int M, N, K; int epi; int rot;
    const float* ssq; int np; float invdim;
    void* o0; void* o1; void* o2; void* o3; const void* i0; const void* i1; float f0;
};
struct Sched {
    int nM, nN, nwg, G, c;
    __device__ void init(int M, int N, int G_, int c_, int rot) { nM = M / BM; nN = N / BM; nwg = nM * nN; G = G_; c = (c_ + G_ - (rot % G_)) % G_; }
    __device__ bool next(int i, Unit& u) const {
        const long L = (long)i * G + c; if (L >= nwg) return false;
        int wgid = (int)L; { const int q = nwg / NXCD, r = nwg % NXCD, xcd = wgid % NXCD, off = wgid / NXCD; wgid = (xcd < r ? xcd * (q + 1) : r * (q + 1) + (xcd - r) * q) + off; }
        const int nig = WGM * nN, gid = wgid / nig, fm = gid * WGM, gsz = (nM - fm) < WGM ? (nM - fm) : WGM;
        u.pm = fm + ((wgid % nig) % gsz); u.pn = (wgid % nig) / gsz; return true;
    }
};

__device__ __forceinline__ float row_rstd(const float* ssq, int np, int row, float invdim) {
    const f32x4* p = (const f32x4*)(ssq + (size_t)row * np); float s = 0.f;
    for (int i = 0; i < (np >> 2); ++i) { const f32x4 v = p[i]; s += (v[0] + v[1]) + (v[2] + v[3]); }
    return rsqrtf(s * invdim + EPS_);
}
__device__ __forceinline__ float sumsq8(f32x4 a, f32x4 b) { return (a[0] * a[0] + a[1] * a[1]) + (a[2] * a[2] + a[3] * a[3]) + (b[0] * b[0] + b[1] * b[1]) + (b[2] * b[2] + b[3] * b[3]); }

__device__ __forceinline__ void epilogue(const f32x4 (&acc)[2][2][4][2], const LAS GemmJob* Jp, int pm, int pn, int wr, int wc, int fr, int fq) {
    const int rbase = pm * BM + wr * 64 + fr;
    const int cl = wc * 32 + 8 * fq;
    const LAS GemmJob& J = *Jp;
    const int epi = __builtin_amdgcn_readfirstlane(J.epi);
    float rs8[2][4];
    if (epi != EPI_RESID && epi != EPI_BF16) {
        const float* ssq = J.ssq; const int np = J.np; const float invdim = J.invdim;
        f32x4 pv[2][4];
#pragma unroll
        for (int ai = 0; ai < 2; ++ai)
#pragma unroll
            for (int m = 0; m < 4; ++m) { const int row = rbase + ai * HALF + m * 16; pv[ai][m] = (4 * fq < np) ? *(const f32x4*)(ssq + (size_t)row * np + 4 * fq) : (f32x4){0.f, 0.f, 0.f, 0.f}; }
#pragma unroll
        for (int ai = 0; ai < 2; ++ai)
#pragma unroll
            for (int m = 0; m < 4; ++m) { float t = (pv[ai][m][0] + pv[ai][m][1]) + (pv[ai][m][2] + pv[ai][m][3]); t += __shfl_xor(t, 16); t += __shfl_xor(t, 32); rs8[ai][m] = rsqrtf(t * invdim + EPS_); }
    } else {
#pragma unroll
        for (int ai = 0; ai < 2; ++ai)
#pragma unroll
            for (int m = 0; m < 4; ++m) rs8[ai][m] = 0.f;
    }
    switch (epi) {
    case EPI_SWIGLU: {
        bf16_t* act = (bf16_t*)J.o0;
#pragma unroll
        for (int ai = 0; ai < 2; ++ai)
#pragma unroll
            for (int m = 0; m < 4; ++m) {
                const int row = rbase + ai * HALF + m * 16; const float rs = rs8[ai][m];
                f32x4 h[2];
#pragma unroll
                for (int n = 0; n < 2; ++n)
#pragma unroll
                    for (int j = 0; j < 4; ++j) { const float g = acc[ai][0][m][n][j] * rs, u = acc[ai][1][m][n][j] * rs; h[n][j] = g * frcp(1.0f + __expf(-g)) * u; }
                *(u32x4*)(act + (size_t)row * FF_ + pn * 128 + cl) = pack8(h[0], h[1]);
            }
    } break;
    case EPI_RESID: case EPI_PLE: {
        bf16_t* xlo = (bf16_t*)J.o0; bf16_t* xbd = (bf16_t*)J.o1; float* ssqo = (float*)J.o2; const bf16_t* xbs = (const bf16_t*)J.i0; const bf16_t* pe = (const bf16_t*)J.i1;
        const bool ple = (epi == EPI_PLE); const float sc = J.f0;
#pragma unroll
        for (int ai = 0; ai < 2; ++ai)
#pragma unroll
        for (int mh = 0; mh < 2; ++mh) {
            u32x4 XH[2][2], XL[2][2];
#pragma unroll
            for (int mm = 0; mm < 2; ++mm)
#pragma unroll
                for (int bj = 0; bj < 2; ++bj) { const int row = rbase + ai * HALF + (2 * mh + mm) * 16; const int col = pn * BM + bj * HALF + cl; XH[mm][bj] = *(const u32x4*)(xbs + (size_t)row * D_ + col); XL[mm][bj] = *(const u32x4*)(xlo + (size_t)row * 2048 + col); }
#pragma unroll
            for (int mm = 0; mm < 2; ++mm) {
                const int m = 2 * mh + mm;
                const int row = rbase + ai * HALF + m * 16; const float rs = rs8[ai][m];
                float ss = 0.f;
#pragma unroll
                for (int bj = 0; bj < 2; ++bj) {
                    const int col = pn * BM + bj * HALF + cl; const size_t off = (size_t)row * D_ + col;
                    const u32x4 h = XH[mm][bj], l = XL[mm][bj];
                    f32x4 x0 = (f32x4){bflo(h.x) + bflo(l.x), bfhi(h.x) + bfhi(l.x), bflo(h.y) + bflo(l.y), bfhi(h.y) + bfhi(l.y)};
                    f32x4 x1 = (f32x4){bflo(h.z) + bflo(l.z), bfhi(h.z) + bfhi(l.z), bflo(h.w) + bflo(l.w), bfhi(h.w) + bfhi(l.w)};
                    f32x4 d0 = acc[ai][bj][m][0], d1 = acc[ai][bj][m][1];
                    if (ple) {
                        const u32x4 pw = *(const u32x4*)(pe + off);
                        d0[0] = sigmoidf_(d0[0] * rs) * bflo(pw.x); d0[1] = sigmoidf_(d0[1] * rs) * bfhi(pw.x); d0[2] = sigmoidf_(d0[2] * rs) * bflo(pw.y); d0[3] = sigmoidf_(d0[3] * rs) * bfhi(pw.y);
                        d1[0] = sigmoidf_(d1[0] * rs) * bflo(pw.z); d1[1] = sigmoidf_(d1[1] * rs) * bfhi(pw.z); d1[2] = sigmoidf_(d1[2] * rs) * bflo(pw.w); d1[3] = sigmoidf_(d1[3] * rs) * bfhi(pw.w);
                    } else { d0 = d0 * sc; d1 = d1 * sc; }
                    x0 = x0 + d0; x1 = x1 + d1;
                    const u32x4 nh = pack8(x0, x1);
                    const f32x4 r0 = (f32x4){x0[0] - bflo(nh.x), x0[1] - bfhi(nh.x), x0[2] - bflo(nh.y), x0[3] - bfhi(nh.y)};
                    const f32x4 r1 = (f32x4){x1[0] - bflo(nh.z), x1[1] - bfhi(nh.z), x1[2] - bflo(nh.w), x1[3] - bfhi(nh.w)};
                    *(u32x4*)(xbd + off) = nh;
                    *(u32x4*)(xlo + (size_t)row * 2048 + col) = pack8(r0, r1);
                    ss += sumsq8(x0, x1);
                }
                ss += __shfl_xor(ss, 16); ss += __shfl_xor(ss, 32);
                if (fq == 0) ssqo[(size_t)row * 16 + pn * 4 + wc] = ss;
            }
        }
    } break;
    case EPI_HGRN: {
        const int sec = pn >> 2; const float* lb = (const float*)J.i0;
#pragma unroll
        for (int ai = 0; ai < 2; ++ai)
#pragma unroll
            for (int m = 0; m < 4; ++m) {
                const int row = rbase + ai * HALF + m * 16; const float rs = rs8[ai][m];
#pragma unroll
                for (int bj = 0; bj < 2; ++bj) {
                    const int cs = (pn & 3) * BM + bj * HALF + cl; const size_t off = (size_t)row * D_ + cs;
                    f32x4 v0 = acc[ai][bj][m][0] * rs, v1 = acc[ai][bj][m][1] * rs;
                    if (sec == 0) { v0 = v0 * 0.08838834764831845f; v1 = v1 * 0.08838834764831845f; *(u32x4*)((bf16_t*)J.o0 + off) = pack8(v0, v1); }
                    else if (sec == 1) {
                        const f32x4 l0 = *(const f32x4*)(lb + cs), l1 = *(const f32x4*)(lb + cs + 4);
#pragma unroll
                        for (int j = 0; j < 4; ++j) { v0[j] = (1.0f - l0[j]) * frcp(1.0f + __expf(v0[j])); v1[j] = (1.0f - l1[j]) * frcp(1.0f + __expf(v1[j])); }
                        *(f32x4*)((float*)J.o1 + off) = v0; *(f32x4*)((float*)J.o1 + off + 4) = v1;
                    } else if (sec == 2) { *(u32x4*)((bf16_t*)J.o2 + off) = pack8(v0, v1); }
                    else {
#pragma unroll
                        for (int j = 0; j < 4; ++j) { v0[j] = sigmoidf_(v0[j]); v1[j] = sigmoidf_(v1[j]); }
                        *(u32x4*)((bf16_t*)J.o3 + off) = pack8(v0, v1);
                    }
                }
            }
    } break;
    case EPI_BF16: {
        bf16_t* o = (bf16_t*)J.o0;
#pragma unroll
        for (int ai = 0; ai < 2; ++ai)
#pragma unroll
            for (int m = 0; m < 4; ++m) {
                const int row = rbase + ai * HALF + m * 16;
#pragma unroll
                for (int bj = 0; bj < 2; ++bj) *(u32x4*)(o + (size_t)row * J.N + pn * BM + bj * HALF + cl) = pack8(acc[ai][bj][m][0], acc[ai][bj][m][1]);
            }
    } break;
    case EPI_CQ: {
        bf16_t* o = (bf16_t*)J.o0; float* so = (float*)J.o1;
#pragma unroll
        for (int ai = 0; ai < 2; ++ai)
#pragma unroll
            for (int m = 0; m < 4; ++m) {
                const int row = rbase + ai * HALF + m * 16; const float rs = rs8[ai][m]; float ss = 0.f;
#pragma unroll
                for (int bj = 0; bj < 2; ++bj) { const f32x4 v0 = acc[ai][bj][m][0] * rs, v1 = acc[ai][bj][m][1] * rs; *(u32x4*)(o + (size_t)row * 512 + pn * BM + bj * HALF + cl) = pack8(v0, v1); ss += sumsq8(v0, v1); }
                ss += __shfl_xor(ss, 16); ss += __shfl_xor(ss, 32);
                if (fq == 0) so[(size_t)row * 8 + pn * 4 + wc] = ss;
            }
    } break;
    case EPI_KVDOWN: {
        bf16_t* ckv = (bf16_t*)J.o0; float* so = (float*)J.o1; bf16_t* kr = (bf16_t*)J.o2; const f32x2* rope = (const f32x2*)J.i0;
        if (pn == 0) {
#pragma unroll
            for (int ai = 0; ai < 2; ++ai)
#pragma unroll
                for (int m = 0; m < 4; ++m) {
                    const int row = rbase + ai * HALF + m * 16; const float rs = rs8[ai][m]; float ss = 0.f;
#pragma unroll
                    for (int bj = 0; bj < 2; ++bj) { const f32x4 v0 = acc[ai][bj][m][0] * rs, v1 = acc[ai][bj][m][1] * rs; *(u32x4*)(ckv + (size_t)row * 256 + bj * HALF + cl) = pack8(v0, v1); ss += sumsq8(v0, v1); }
                    ss += __shfl_xor(ss, 16); ss += __shfl_xor(ss, 32);
                    if (fq == 0) so[(size_t)row * 4 + wc] = ss;
                }
        } else if (wc == 0) {
#pragma unroll
            for (int ai = 0; ai < 2; ++ai)
#pragma unroll
                for (int m = 0; m < 4; ++m) {
                    const int row = rbase + ai * HALF + m * 16; const float rs = rs8[ai][m];
                    f32x4 a[2], b[2];
#pragma unroll
                    for (int n = 0; n < 2; ++n)
#pragma unroll
                        for (int j = 0; j < 4; ++j) { const f32x2 cs = rope[(size_t)row * 32 + 8 * fq + 4 * n + j]; const float x1 = acc[ai][0][m][n][j] * rs, x2 = acc[ai][1][m][n][j] * rs; a[n][j] = x1 * cs.x - x2 * cs.y; b[n][j] = x2 * cs.x + x1 * cs.y; }
                    *(u32x4*)(kr + (size_t)row * 64 + 8 * fq) = pack8(a[0], a[1]); *(u32x4*)(kr + (size_t)row * 64 + 32 + 8 * fq) = pack8(b[0], b[1]);
                }
        }
    } break;
    case EPI_KVUP: {
        bf16_t* kn = (bf16_t*)J.o0; bf16_t* vt = (bf16_t*)J.o1;
#pragma unroll
        for (int ai = 0; ai < 2; ++ai)
#pragma unroll
            for (int m = 0; m < 4; ++m) {
                const int row = rbase + ai * HALF + m * 16; const float rs = rs8[ai][m];
                const int b = row >> 13, s = row & (S_ - 1); const size_t bh = (size_t)b * 16 + pn;
                *(u32x4*)(kn + (bh * S_ + s) * 128 + cl) = pack8(acc[ai][0][m][0] * rs, acc[ai][0][m][1] * rs);
                const u32x4 w = pack8(acc[ai][1][m][0] * rs, acc[ai][1][m][1] * rs);
                const int sp = (s & ~15) | (((s >> 2) & 1) << 3) | (((s >> 3) & 1) << 2) | (s & 3);
                bf16_t* vp = vt + (bh * 128 + cl) * S_ + sp;
                vp[0 * S_] = (bf16_t)(w.x & 0xffff); vp[1 * S_] = (bf16_t)(w.x >> 16); vp[2 * S_] = (bf16_t)(w.y & 0xffff); vp[3 * S_] = (bf16_t)(w.y >> 16);
                vp[4 * S_] = (bf16_t)(w.z & 0xffff); vp[5 * S_] = (bf16_t)(w.z >> 16); vp[6 * S_] = (bf16_t)(w.w & 0xffff); vp[7 * S_] = (bf16_t)(w.w >> 16);
            }
    } break;
    case EPI_QUP: {
        bf16_t* qn = (bf16_t*)J.o0; bf16_t* qr = (bf16_t*)J.o1; const f32x2* rope = (const f32x2*)J.i0;
#pragma unroll
        for (int ai = 0; ai < 2; ++ai)
#pragma unroll
            for (int m = 0; m < 4; ++m) {
                const int row = rbase + ai * HALF + m * 16; const float rs = rs8[ai][m] * J.f0;
                if (pn < 8) {
#pragma unroll
                    for (int bj = 0; bj < 2; ++bj) *(u32x4*)(qn + (size_t)row * 2048 + pn * BM + bj * HALF + cl) = pack8(acc[ai][bj][m][0] * rs, acc[ai][bj][m][1] * rs);
                } else {
                    const int head = 4 * (pn - 8) + wc; f32x4 a[2], b[2];
#pragma unroll
                    for (int n = 0; n < 2; ++n)
#pragma unroll
                        for (int j = 0; j < 4; ++j) { const f32x2 cs = rope[(size_t)row * 32 + 8 * fq + 4 * n + j]; const float x1 = acc[ai][0][m][n][j] * rs, x2 = acc[ai][1][m][n][j] * rs; a[n][j] = x1 * cs.x - x2 * cs.y; b[n][j] = x2 * cs.x + x1 * cs.y; }
                    *(u32x4*)(qr + (size_t)row * 2048 + head * 64 + 8 * fq) = pack8(a[0], a[1]); *(u32x4*)(qr + (size_t)row * 2048 + head * 64 + 32 + 8 * fq) = pack8(b[0], b[1]);
                }
            }
    } break;
    default: break;
    }
}

__device__ __forceinline__ const char* rfl_ptr(const void* p) { const unsigned long long v = (unsigned long long)p; const unsigned lo = __builtin_amdgcn_readfirstlane((unsigned)v), hi = __builtin_amdgcn_readfirstlane((unsigned)(v >> 32)); return (const char*)(((unsigned long long)hi << 32) | lo); }
template <bool ALIGN_EPI, bool SP2>
__device__ __forceinline__ void gemm_phase(LAS unsigned char* lds, const LAS GemmJob* g, const Sched& S) {
    const int tid = tid_opaque(), wid = __builtin_amdgcn_readfirstlane(tid >> 6), lane = tid & 63, wr = wid >> 2, wc = wid & 3, fr = lane & 15, fq = lane >> 4;
    const int K = __builtin_amdgcn_readfirstlane(g->K), nt = K / BK;
    const char* gA = rfl_ptr(g->A); const char* gB = rfl_ptr(g->Bt);
    unsigned voffA[2], voffB[2];
#pragma unroll
    for (int i = 0; i < 2; ++i) { int R, C; stage_rc(tid * 16 + i * 8192, R, C); const int Rb = (R & ~31) + perm32(R & 31);
        voffA[i] = (unsigned)(R * K + C) * 2u; voffB[i] = (unsigned)(Rb * K + C) * 2u; }
    const size_t kstep = (size_t)(BK * 2);
    const size_t hstep = (size_t)HALF * K * 2;
    const size_t tstep = 2 * hstep;
    const unsigned ldsw = (unsigned)wid * 1024u;
    const int aoff = lds_byte(wr * 64 + fr, fq * 8), boff = lds_byte(wc * 32 + fr, fq * 8);
#define PG8_SA(b, h) (((b) * 2 + (h)) * HTB)
#define PG8_SB(b, h) ((4 + (b) * 2 + (h)) * HTB)
#define PG8_STAGE(bufoff, gbase, voff) do { _Pragma("unroll") for (int _i = 0; _i < 2; ++_i) \
        __builtin_amdgcn_global_load_lds((const unsigned*)((const char*)(gbase) + (voff)[_i]), (LAS unsigned*)(lds + (bufoff) + ldsw + _i * 8192), 16, 0, 0); } while (0)
#define PG8_LDA(dst, b, h) do { _Pragma("unroll") for (int m = 0; m < 4; ++m) _Pragma("unroll") for (int k = 0; k < 2; ++k) dst[m][k] = *(const LAS bf16x8*)(lds + PG8_SA(b, h) + aoff + m * 2048 + k * 1024); } while (0)
#define PG8_LDB(dst, b, h) do { _Pragma("unroll") for (int n = 0; n < 2; ++n) _Pragma("unroll") for (int k = 0; k < 2; ++k) dst[n][k] = *(const LAS bf16x8*)(lds + PG8_SB(b, h) + boff + n * 2048 + k * 1024); } while (0)
#define PG8_MMA(ai, bj, At, Bt) do { __builtin_amdgcn_s_setprio(1); _Pragma("unroll") for (int m = 0; m < 4; ++m) _Pragma("unroll") for (int n = 0; n < 2; ++n) _Pragma("unroll") for (int k = 0; k < 2; ++k) \
        acc[ai][bj][m][n] = __builtin_amdgcn_mfma_f32_16x16x32_bf16(Bt[n][k], At[m][k], acc[ai][bj][m][n], 0, 0, 0); __builtin_amdgcn_s_setprio(0); } while (0)
#define PG8_WAIT_V(n) asm volatile("s_waitcnt vmcnt(" #n ")" ::: "memory")
#define PG8_WAIT_L(n) asm volatile("s_waitcnt lgkmcnt(" #n ")" ::: "memory")
#define PG8_BAR __builtin_amdgcn_s_barrier()
#define PG8_SCHED __builtin_amdgcn_sched_barrier(0)
    Unit cur, nxt; int ui = 0;
    if (!S.next(0, cur)) return;
    f32x4 acc[2][2][4][2];
#pragma unroll
    for (int a = 0; a < 2; ++a)
#pragma unroll
        for (int b = 0; b < 2; ++b)
#pragma unroll
            for (int m = 0; m < 4; ++m)
#pragma unroll
                for (int n = 0; n < 2; ++n) acc[a][b][m][n] = (f32x4){0.f, 0.f, 0.f, 0.f};
    bf16x8 At[4][2], B0[2][2], B1[2][2];
    const char* cA = gA + (size_t)cur.pm * tstep; const char* cB = gB + (size_t)cur.pn * tstep;
    if constexpr (SP2) {
        PG8_STAGE(PG8_SB(0, 0), cB, voffB); PG8_STAGE(PG8_SB(0, 1), cB + hstep, voffB); PG8_STAGE(PG8_SA(0, 0), cA, voffA); PG8_STAGE(PG8_SA(0, 1), cA + hstep, voffA);
        if (wr == 1) PG8_BAR;
        PG8_WAIT_V(2); PG8_BAR;
        PG8_STAGE(PG8_SB(1, 0), cB + kstep, voffB); PG8_STAGE(PG8_SA(1, 0), cA + kstep, voffA); PG8_STAGE(PG8_SB(1, 1), cB + hstep + kstep, voffB);
        PG8_WAIT_V(6); PG8_BAR;
    } else {
        PG8_STAGE(PG8_SB(0, 0), cB, voffB); PG8_STAGE(PG8_SA(0, 0), cA, voffA); PG8_STAGE(PG8_SB(0, 1), cB + hstep, voffB); PG8_STAGE(PG8_SA(0, 1), cA + hstep, voffA);
        if (wr == 1) PG8_BAR;
        PG8_WAIT_V(4); PG8_BAR;
        PG8_STAGE(PG8_SB(1, 0), cB + kstep, voffB); PG8_STAGE(PG8_SA(1, 0), cA + kstep, voffA); PG8_STAGE(PG8_SB(1, 1), cB + hstep + kstep, voffB);
        PG8_WAIT_V(6); PG8_BAR;
    }
    for (;;) {
        const bool has_next = S.next(ui + 1, nxt);
        const char* nA = has_next ? gA + (size_t)nxt.pm * tstep : cA; const char* nB = has_next ? gB + (size_t)nxt.pn * tstep : cB;
        for (int t = 0; t < nt; t += 2) {
            const bool last = (t == nt - 2);
            const char* a1 = cA + (size_t)(t + 1) * kstep;
            const char* a2 = last ? nA : cA + (size_t)(t + 2) * kstep; const char* b2 = last ? nB : cB + (size_t)(t + 2) * kstep;
            const char* a3 = a2 + kstep; const char* b3 = b2 + kstep;
            if constexpr (SP2) {
            PG8_LDB(B0, 0, 0); PG8_LDB(B1, 0, 1); PG8_SCHED; PG8_LDA(At, 0, 0); PG8_STAGE(PG8_SA(1, 1), a1 + hstep, voffA);
            PG8_WAIT_V(8); PG8_WAIT_L(0); PG8_BAR; PG8_MMA(0, 0, At, B0); PG8_MMA(0, 1, At, B1); PG8_BAR; PG8_SCHED;
            PG8_LDA(At, 0, 1); PG8_STAGE(PG8_SB(0, 0), b2, voffB); PG8_STAGE(PG8_SB(0, 1), b2 + hstep, voffB); PG8_STAGE(PG8_SA(0, 0), a2, voffA);
            PG8_WAIT_V(8); PG8_WAIT_L(0); PG8_BAR; PG8_MMA(1, 0, At, B0); PG8_MMA(1, 1, At, B1); PG8_BAR; PG8_SCHED;
            PG8_LDB(B0, 1, 0); PG8_LDB(B1, 1, 1); PG8_SCHED; PG8_LDA(At, 1, 0); PG8_STAGE(PG8_SA(0, 1), a2 + hstep, voffA);
            PG8_WAIT_V(8); PG8_WAIT_L(0); PG8_BAR; PG8_MMA(0, 0, At, B0); PG8_MMA(0, 1, At, B1); PG8_BAR; PG8_SCHED;
            PG8_LDA(At, 1, 1); PG8_STAGE(PG8_SB(1, 0), b3, voffB); PG8_STAGE(PG8_SB(1, 1), b3 + hstep, voffB); PG8_STAGE(PG8_SA(1, 0), a3, voffA);
            PG8_WAIT_V(8); PG8_WAIT_L(0); PG8_BAR; PG8_MMA(1, 0, At, B0); PG8_MMA(1, 1, At, B1); PG8_BAR; PG8_SCHED;
            } else {
            PG8_LDB(B0, 0, 0); PG8_SCHED; PG8_LDA(At, 0, 0); PG8_STAGE(PG8_SA(1, 1), a1 + hstep, voffA);
            PG8_WAIT_L(8); PG8_BAR; PG8_WAIT_L(0); PG8_MMA(0, 0, At, B0); PG8_BAR; PG8_SCHED;
            PG8_LDB(B1, 0, 1); PG8_STAGE(PG8_SB(0, 0), b2, voffB);
            PG8_BAR; PG8_WAIT_L(0); PG8_MMA(0, 1, At, B1); PG8_BAR;
            PG8_LDA(At, 0, 1); PG8_STAGE(PG8_SA(0, 0), a2, voffA);
            PG8_BAR; PG8_WAIT_L(0); PG8_MMA(1, 0, At, B0); PG8_BAR; PG8_SCHED;
            PG8_STAGE(PG8_SB(0, 1), b2 + hstep, voffB);
            PG8_WAIT_V(6); PG8_BAR; PG8_MMA(1, 1, At, B1); PG8_BAR;
            PG8_LDB(B0, 1, 0); PG8_SCHED; PG8_LDA(At, 1, 0); PG8_STAGE(PG8_SA(0, 1), a2 + hstep, voffA);
            PG8_WAIT_L(8); PG8_BAR; PG8_WAIT_L(0); PG8_MMA(0, 0, At, B0); PG8_BAR; PG8_SCHED;
            PG8_LDB(B1, 1, 1); PG8_STAGE(PG8_SB(1, 0), b3, voffB);
            PG8_BAR; PG8_WAIT_L(0); PG8_MMA(0, 1, At, B1); PG8_BAR;
            PG8_LDA(At, 1, 1); PG8_STAGE(PG8_SA(1, 0), a3, voffA);
            PG8_BAR; PG8_WAIT_L(0); PG8_MMA(1, 0, At, B0); PG8_BAR; PG8_SCHED;
            PG8_STAGE(PG8_SB(1, 1), b3 + hstep, voffB);
            PG8_WAIT_V(6); PG8_BAR; PG8_MMA(1, 1, At, B1); PG8_BAR;
            }
        }
        if constexpr (ALIGN_EPI) { if (wr == 0) PG8_BAR; }
        epilogue(acc, g, cur.pm, cur.pn, wr, wc, fr, fq);
        if (!has_next) break;
#pragma unroll
        for (int a = 0; a < 2; ++a)
#pragma unroll
            for (int b = 0; b < 2; ++b)
#pragma unroll
                for (int m = 0; m < 4; ++m)
#pragma unroll
                    for (int n = 0; n < 2; ++n) acc[a][b][m][n] = (f32x4){0.f, 0.f, 0.f, 0.f};
        cur = nxt; cA = nA; cB = nB; ++ui;
        if constexpr (ALIGN_EPI) { if (wr == 1) PG8_BAR; }
    }
    PG8_WAIT_V(0);
    if constexpr (!ALIGN_EPI) { if (wr == 0) PG8_BAR; }
    PG8_BAR;
#undef PG8_SA
#undef PG8_SB
#undef PG8_STAGE
#undef PG8_LDA
#undef PG8_LDB
#undef PG8_MMA
#undef PG8_WAIT_V
#undef PG8_WAIT_L
#undef PG8_BAR
#undef PG8_SCHED
}

struct TJob { const float* src; int ld, K, N; bf16_t* dst; const float* gain; int kind; };
__device__ __forceinline__ int wmap(int kind, int n) {
    if (kind == 0) return n;
    if (kind == 1) { const int pn = n >> 8, r = n & 255; return (r >> 7) * FF_ + pn * 128 + (r & 127); }
    if (kind == 2) { if (n < 256) return n; const int r = n - 256, half = r >> 7, rr = r & 127; return (r < 256 && rr < 32) ? 256 + half * 32 + rr : -1; }
    { if (n < 2048) return (n >> 7) * 192 + (n & 127); const int nn = n - 2048, t = nn >> 8, r = nn & 255, half = r >> 7, hl = (r & 127) >> 5, i = r & 31; return (4 * t + hl) * 192 + 128 + half * 32 + i; }
}
__device__ __forceinline__ TJob get_tjob(const KP& P, int j) {
    TJob t; unsigned char* ws = P.ws; t.gain = nullptr; t.kind = 0;
    if (j < 4) { const int l = j >> 1, jj = j & 1; t.src = P.in[4] + (size_t)j * D_ * 2 * FF_; t.ld = 2 * FF_; t.K = D_; t.N = 2 * FF_; t.dst = (bf16_t*)(ws + OFF_FI + j * SZ_FI); t.gain = P.in[3] + (l * 4 + (jj ? 2 : 0)) * D_; t.kind = 1; }
    else if (j < 8) { const int i = j - 4; t.src = P.in[5] + (size_t)i * FF_ * D_; t.ld = D_; t.K = FF_; t.N = D_; t.dst = (bf16_t*)(ws + OFF_FO + i * SZ_FO); }
    else if (j < 10) { const int l = j - 8; t.src = P.in[6] + (size_t)l * D_ * D_; t.ld = D_; t.K = D_; t.N = D_; t.dst = (bf16_t*)(ws + OFF_PG + l * 2 * MiB); t.gain = P.in[3] + (l * 4 + 3) * D_; }
    else if (j < 12) { const int l = j - 10; t.src = P.in[7] + (size_t)l * 256 * D_; t.ld = D_; t.K = 256; t.N = D_; t.dst = (bf16_t*)(ws + OFF_PI + l * (MiB / 2)); }
    else if (j == 12) { t.src = P.in[8]; t.ld = 4096; t.K = D_; t.N = 4096; t.dst = (bf16_t*)(ws + OFF_AIN); t.gain = P.in[3] + 1 * D_; }
    else if (j == 13) { t.src = P.in[11]; t.ld = D_; t.K = D_; t.N = D_; t.dst = (bf16_t*)(ws + OFF_AOUT); }
    else if (j == 14) { t.src = P.in[13]; t.ld = 320; t.K = D_; t.N = 512; t.dst = (bf16_t*)(ws + OFF_KVD); t.gain = P.in[12]; t.kind = 2; }
    else if (j == 15) { t.src = P.in[15]; t.ld = 4096; t.K = 256; t.N = 4096; t.dst = (bf16_t*)(ws + OFF_KVU); t.gain = P.in[14]; }
    else if (j == 16) { t.src = P.in[16]; t.ld = 512; t.K = D_; t.N = 512; t.dst = (bf16_t*)(ws + OFF_DQ); t.gain = P.in[3] + (4 + 1) * D_; }
    else if (j == 17) { t.src = P.in[18]; t.ld = 3072; t.K = 512; t.N = 3072; t.dst = (bf16_t*)(ws + OFF_UQ); t.gain = P.in[17]; t.kind = 3; }
    else { t.src = P.in[19]; t.ld = D_; t.K = 2048; t.N = D_; t.dst = (bf16_t*)(ws + OFF_BO); }
    return t;
}
constexpr int N_TJOBS = 19;

__device__ void prep_phase(const KP& P, LAS unsigned char* lds) {
    const int tid = tid_opaque(), wid = tid >> 6, lane = tid & 63;
    unsigned char* ws = P.ws;
    LAS bf16_t* tile = (LAS bf16_t*)lds;
    for (int j = 0; j < N_TJOBS; ++j) {
        const TJob tj = get_tjob(P, j);
        const int nkt = tj.K >> 7, ntiles = nkt * (tj.N >> 6);
        for (int t = (blockIdx.x + j * 37) % gridDim.x; t < ntiles; t += gridDim.x) {
            const int ntile = t / nkt, kt = t - ntile * nkt;
            const int nn = tid & 63, kr = tid >> 6;
            const int col = wmap(tj.kind, ntile * 64 + nn);
            float vals[16];
#pragma unroll
            for (int i = 0; i < 16; ++i) { const int k = kt * 128 + kr + 8 * i; vals[i] = (col >= 0) ? tj.src[(size_t)k * tj.ld + col] : 0.f; }
            if (tj.gain) {
#pragma unroll
                for (int i = 0; i < 16; ++i) vals[i] *= tj.gain[kt * 128 + kr + 8 * i];
            }
#pragma unroll
            for (int i = 0; i < 16; ++i) tile[nn * 136 + kr + 8 * i] = (bf16_t)(cvt_pk_bf16(vals[i], 0.f) & 0xffff);
            __syncthreads();
#pragma unroll
            for (int c2 = 0; c2 < 2; ++c2) { const int ci = tid + 512 * c2, r = ci >> 4, ch = ci & 15; const u32x4 w = *(const LAS u32x4*)(tile + r * 136 + ch * 8); *(u32x4*)(tj.dst + (size_t)(ntile * 64 + r) * tj.K + kt * 128 + ch * 8) = w; }
            __syncthreads();
        }
    }
    const int gtid = blockIdx.x * 512 + tid, gthreads = gridDim.x * 512;
    { const float* p = P.in[1]; bf16_t* pb = (bf16_t*)(ws + OFF_PB);
      for (int i = gtid; i < 2 * T_ * 256 / 4; i += gthreads) { const f32x4 v = *(const f32x4*)(p + (size_t)i * 4); u32x2 w; w.x = cvt_pk_bf16(v[0], v[1]); w.y = cvt_pk_bf16(v[2], v[3]); *(u32x2*)(pb + (size_t)i * 4) = w; } }
    { const float* x = P.in[0]; bf16_t* xb = (bf16_t*)(ws + OFF_XB); bf16_t* xlo = (bf16_t*)P.out; float* ssq = (float*)(ws + OFF_SSQ0);
      for (int row = blockIdx.x * 8 + wid; row < T_; row += gridDim.x * 8) {
          float ss = 0.f;
#pragma unroll
          for (int i = 0; i < 4; ++i) { const size_t off = (size_t)row * D_ + i * 256 + lane * 4; const f32x4 v = *(const f32x4*)(x + off); ss += (v[0] * v[0] + v[1] * v[1]) + (v[2] * v[2] + v[3] * v[3]); u32x2 w; w.x = cvt_pk_bf16(v[0], v[1]); w.y = cvt_pk_bf16(v[2], v[3]); *(u32x2*)(xb + off) = w;
              u32x2 l; l.x = cvt_pk_bf16(v[0] - bflo(w.x), v[1] - bfhi(w.x)); l.y = cvt_pk_bf16(v[2] - bflo(w.y), v[3] - bfhi(w.y)); *(u32x2*)(xlo + (size_t)row * 2048 + i * 256 + lane * 4) = l; }
#pragma unroll
          for (int o = 32; o > 0; o >>= 1) ss += __shfl_xor(ss, o);
          if (lane < 16) ssq[(size_t)row * 16 + lane] = (lane == 0) ? ss : 0.f;
      } }
    if (blockIdx.x == 0) { const float* lg = P.in[9]; float* lb = (float*)(ws + OFF_LB); for (int i = tid; i < 1024; i += 512) lb[i] = 1.0f / (1.0f + expf(lg[1024 + i] - lg[i])); }
    { const int* pos = (const int*)P.in[2]; f32x2* rope = (f32x2*)(ws + OFF_ROPE);
      for (int i = gtid; i < T_ * 32; i += gthreads) {
          const int row = i >> 5, f = i & 31;
          const float inv = P.inv_freq[f];
          const float ang = (float)pos[row] * inv;
          const double a = (double)ang; const double k = rint(a * 0.15915494309189535); double r = fma(-k, 6.283185307179586, a); r = fma(-k, 2.4492935982947064e-16, r);
          const float rf = (float)r; f32x2 cs; cs.x = cosf(rf); cs.y = sinf(rf); rope[i] = cs;
      } }
}

__device__ __forceinline__ size_t u_byte(int row0, int h, int vd) { return ((size_t)(row0 + (vd >> 1)) * D_ + h * 128) * 4 + (vd & 1) * 256; }

__device__ void hgrn_a(const KP& P, LAS unsigned char* lds) {
    unsigned char* ws = P.ws;
    bf16_t* q = (bf16_t*)(ws + OFF_HQ); float* kk = (float*)(ws + OFF_HKK); unsigned char* kkb = ws + OFF_HKK; const bf16_t* v = (const bf16_t*)(ws + OFF_HV); bf16_t* Kn = (bf16_t*)(ws + OFF_HKN); float* dec = (float*)(ws + OFF_DEC);
    LAS bf16_t* sKl = (LAS bf16_t*)lds; LAS bf16_t* sVt = (LAS bf16_t*)(lds + 18432); LAS float* tot = (LAS float*)(lds + 36864);
    const int tid = tid_opaque(), wid = tid >> 6, lane = tid & 63, fr = lane & 15, fq = lane >> 4;
    const int k = tid & 127, rg = tid >> 7;
    for (int u = blockIdx.x; u < 2048; u += gridDim.x) {
        const int bh = u >> 7, c = u & 127, b = bh >> 3, h = bh & 7;
        const int row0 = b * S_ + c * 64; const size_t base = (size_t)(row0 + rg * 16) * D_ + h * 128 + k;
        float kv[16], bb[16]; float run = 0.f; unsigned short qraw[16], vraw[16];
#pragma unroll
        for (int r = 0; r < 16; ++r) kv[r] = kk[base + (size_t)r * D_];
#pragma unroll
        for (int r = 0; r < 16; ++r) { qraw[r] = q[base + (size_t)r * D_]; vraw[r] = v[base + (size_t)r * D_]; }
#pragma unroll
        for (int r = 0; r < 16; ++r) { run += __logf(1.0f - kv[r]); bb[r] = run; }
        tot[rg * 128 + k] = run;
        __syncthreads();
        float pre = 0.f, total = 0.f;
#pragma unroll
        for (int g = 0; g < 4; ++g) { const float t = tot[g * 128 + k]; if (g < rg) pre += t; total += t; }
        unsigned klp[8], vtp[8];
#pragma unroll
        for (int r = 0; r < 16; r += 2) {
            const float b0 = bb[r] + pre, b1 = bb[r + 1] + pre;
            const float q0 = bf2f(qraw[r]) * __expf(b0), q1 = bf2f(qraw[r + 1]) * __expf(b1);
            q[base + (size_t)r * D_] = (bf16_t)(cvt_pk_bf16(q0, 0.f) & 0xffff); q[base + (size_t)(r + 1) * D_] = (bf16_t)(cvt_pk_bf16(q1, 0.f) & 0xffff);
            const float n0 = kv[r] * __expf(-b0), n1 = kv[r + 1] * __expf(-b1);
            Kn[base + (size_t)r * D_] = (bf16_t)(cvt_pk_bf16(n0, 0.f) & 0xffff); Kn[base + (size_t)(r + 1) * D_] = (bf16_t)(cvt_pk_bf16(n1, 0.f) & 0xffff);
            klp[r >> 1] = cvt_pk_bf16(kv[r] * __expf(total - b0), kv[r + 1] * __expf(total - b1));
            vtp[r >> 1] = (unsigned)vraw[r] | ((unsigned)vraw[r + 1] << 16);
        }
        *(LAS u32x4*)(sKl + k * 72 + rg * 16) = (u32x4){klp[0], klp[1], klp[2], klp[3]}; *(LAS u32x4*)(sKl + k * 72 + rg * 16 + 8) = (u32x4){klp[4], klp[5], klp[6], klp[7]};
        *(LAS u32x4*)(sVt + k * 72 + rg * 16) = (u32x4){vtp[0], vtp[1], vtp[2], vtp[3]}; *(LAS u32x4*)(sVt + k * 72 + rg * 16 + 8) = (u32x4){vtp[4], vtp[5], vtp[6], vtp[7]};
        if (rg == 0) dec[(size_t)u * 128 + k] = __expf(total);
        __syncthreads();
        const int vb = wid * 16;
        bf16x8 bfr[2];
#pragma unroll
        for (int ks = 0; ks < 2; ++ks) bfr[ks] = *(const LAS bf16x8*)(sVt + (vb + fr) * 72 + ks * 32 + fq * 8);
#pragma unroll
        for (int kb = 0; kb < 8; ++kb) {
            f32x4 a4 = (f32x4){0.f, 0.f, 0.f, 0.f};
#pragma unroll
            for (int ks = 0; ks < 2; ++ks) { const bf16x8 afr = *(const LAS bf16x8*)(sKl + (kb * 16 + fr) * 72 + ks * 32 + fq * 8); a4 = __builtin_amdgcn_mfma_f32_16x16x32_bf16(afr, bfr[ks], a4, 0, 0, 0); }
            u32x2 w; w.x = cvt_pk_bf16(a4[0], a4[1]); w.y = cvt_pk_bf16(a4[2], a4[3]);
                        *(u32x2*)(kkb + u_byte(row0, h, vb + fr) + (kb * 16 + fq * 4) * 2) = w;
        }
        __syncthreads();
    }
}

__device__ void hgrn_b(const KP& P) {
    unsigned char* ws = P.ws; unsigned char* kkb = ws + OFF_HKK; const float* dec = (const float*)(ws + OFF_DEC);
    const int tid = tid_opaque();
    for (int item = blockIdx.x * 512 + tid; item < 16 * 8192; item += gridDim.x * 512) {
        const int bh = item >> 13, e2 = item & 8191, vd = e2 >> 6, k2 = (e2 & 63) * 2, b = bh >> 3, h = bh & 7;
        float s0 = 0.f, s1 = 0.f;
        for (int c0 = 0; c0 < 128; c0 += 16) {
            unsigned uu[16]; f32x2 dd[16];
#pragma unroll
            for (int i = 0; i < 16; ++i) { const int c = c0 + i; uu[i] = *(const unsigned*)(kkb + u_byte(b * S_ + c * 64, h, vd) + k2 * 2); dd[i] = *(const f32x2*)(dec + (size_t)(bh * 128 + c) * 128 + k2); }
#pragma unroll
            for (int i = 0; i < 16; ++i) { const int c = c0 + i; *(unsigned*)(kkb + u_byte(b * S_ + c * 64, h, vd) + k2 * 2) = cvt_pk_bf16(s0, s1); s0 = dd[i].x * s0 + bflo(uu[i]); s1 = dd[i].y * s1 + bfhi(uu[i]); }
        }
    }
}

__device__ void hgrn_c(const KP& P, LAS unsigned char* lds) {
    unsigned char* ws = P.ws;
    bf16_t* q = (bf16_t*)(ws + OFF_HQ); unsigned char* kkb = ws + OFF_HKK; const bf16_t* v = (const bf16_t*)(ws + OFF_HV); const bf16_t* Kn = (const bf16_t*)(ws + OFF_HKN); const bf16_t* og = (const bf16_t*)(ws + OFF_HOG);
    const float* gain = P.in[10];
    LAS bf16_t* sQ = (LAS bf16_t*)lds; LAS bf16_t* sK = (LAS bf16_t*)(lds + 17408); LAS bf16_t* sVt = (LAS bf16_t*)(lds + 34816); LAS bf16_t* sS = (LAS bf16_t*)(lds + 53248); LAS bf16_t* sP = (LAS bf16_t*)(lds + 88064); LAS float* red = (LAS float*)(lds + 97280);
    const int tid = tid_opaque(), wid = tid >> 6, lane = tid & 63, fr = lane & 15, fq = lane >> 4;
    for (int u = blockIdx.x; u < 2048; u += gridDim.x) {
        const int bh = u >> 7, c = u & 127, b = bh >> 3, h = bh & 7; const int row0 = b * S_ + c * 64;
#pragma unroll
        for (int i = 0; i < 2; ++i) { const int ci = tid + 512 * i, r = ci >> 4, ch = ci & 15; const size_t g = (size_t)(row0 + r) * D_ + h * 128 + ch * 8;
            *(LAS u32x4*)(sQ + r * 136 + ch * 8) = *(const u32x4*)(q + g); *(LAS u32x4*)(sK + r * 136 + ch * 8) = *(const u32x4*)(Kn + g); }
#pragma unroll
        for (int i = 0; i < 4; ++i) { const int ci = tid + 512 * i, vd = ci >> 4, ch = ci & 15; *(LAS u32x4*)(sS + vd * 136 + ch * 8) = *(const u32x4*)(kkb + u_byte(row0, h, vd) + ch * 16); }
        { const int k = tid & 127, rg = tid >> 7; const size_t base = (size_t)(row0 + rg * 16) * D_ + h * 128 + k; unsigned vtp[8];
#pragma unroll
          for (int r = 0; r < 16; r += 2) vtp[r >> 1] = (unsigned)v[base + (size_t)r * D_] | ((unsigned)v[base + (size_t)(r + 1) * D_] << 16);
          *(LAS u32x4*)(sVt + k * 72 + rg * 16) = (u32x4){vtp[0], vtp[1], vtp[2], vtp[3]}; *(LAS u32x4*)(sVt + k * 72 + rg * 16 + 8) = (u32x4){vtp[4], vtp[5], vtp[6], vtp[7]}; }
        const int tb = (wid >> 1) * 16, wh = wid & 1;
        u32x2 ogw[4]; f32x4 gnv[4];
#pragma unroll
        for (int j = 0; j < 4; ++j) { const int vd0 = wh * 64 + j * 16 + 4 * fq; ogw[j] = *(const u32x2*)(og + (size_t)(row0 + tb + fr) * D_ + h * 128 + vd0); gnv[j] = *(const f32x4*)(gain + vd0); }
        __syncthreads();
        bf16x8 bq[4];
#pragma unroll
        for (int ks = 0; ks < 4; ++ks) bq[ks] = *(const LAS bf16x8*)(sQ + (tb + fr) * 136 + ks * 32 + fq * 8);
#pragma unroll
        for (int j = 0; j < 2; ++j) {
            const int sb = (wh * 2 + j) * 16; f32x4 a4 = (f32x4){0.f, 0.f, 0.f, 0.f};
#pragma unroll
            for (int ks = 0; ks < 4; ++ks) { const bf16x8 a = *(const LAS bf16x8*)(sK + (sb + fr) * 136 + ks * 32 + fq * 8); a4 = __builtin_amdgcn_mfma_f32_16x16x32_bf16(a, bq[ks], a4, 0, 0, 0); }
            const int t = tb + fr, s0 = sb + 4 * fq;
#pragma unroll
            for (int e = 0; e < 4; ++e) if (s0 + e > t) a4[e] = 0.f;
            u32x2 w; w.x = cvt_pk_bf16(a4[0], a4[1]); w.y = cvt_pk_bf16(a4[2], a4[3]);
            *(LAS u32x2*)(sP + t * 72 + s0) = w;
        }
        __syncthreads();
        bf16x8 bp[2];
#pragma unroll
        for (int ks = 0; ks < 2; ++ks) bp[ks] = *(const LAS bf16x8*)(sP + (tb + fr) * 72 + ks * 32 + fq * 8);
        f32x4 o[4]; float ss = 0.f;
#pragma unroll
        for (int j = 0; j < 4; ++j) {
            const int vb = wh * 64 + j * 16; f32x4 a4 = (f32x4){0.f, 0.f, 0.f, 0.f};
#pragma unroll
            for (int ks = 0; ks < 4; ++ks) { const bf16x8 a = *(const LAS bf16x8*)(sS + (vb + fr) * 136 + ks * 32 + fq * 8); a4 = __builtin_amdgcn_mfma_f32_16x16x32_bf16(a, bq[ks], a4, 0, 0, 0); }
#pragma unroll
            for (int ks = 0; ks < 2; ++ks) { const bf16x8 a = *(const LAS bf16x8*)(sVt + (vb + fr) * 72 + ks * 32 + fq * 8); a4 = __builtin_amdgcn_mfma_f32_16x16x32_bf16(a, bp[ks], a4, 0, 0, 0); }
            o[j] = a4; ss += (a4[0] * a4[0] + a4[1] * a4[1]) + (a4[2] * a4[2] + a4[3] * a4[3]);
        }
        ss += __shfl_xor(ss, 16); ss += __shfl_xor(ss, 32);
        if (fq == 0) red[(tb + fr) * 2 + wh] = ss;
        __syncthreads();
        const float rstd = rsqrtf((red[(tb + fr) * 2] + red[(tb + fr) * 2 + 1]) * (1.0f / 128.0f) + EPS_);
#pragma unroll
        for (int j = 0; j < 4; ++j) {
            const int vd0 = wh * 64 + j * 16 + 4 * fq; const size_t g = (size_t)(row0 + tb + fr) * D_ + h * 128 + vd0;
            const f32x4 gn = gnv[j]; const u32x2 ow = ogw[j];
            u32x2 w; w.x = cvt_pk_bf16(o[j][0] * rstd * gn[0] * bflo(ow.x), o[j][1] * rstd * gn[1] * bfhi(ow.x)); w.y = cvt_pk_bf16(o[j][2] * rstd * gn[2] * bflo(ow.y), o[j][3] * rstd * gn[3] * bfhi(ow.y));
            *(u32x2*)(q + g) = w;
        }
        __syncthreads();
    }
}

__device__ void attn_phase(const KP& P, LAS unsigned char* lds, bool dummy = false) {
    unsigned char* ws = P.ws;
    bf16_t* Qn = (bf16_t*)(ws + OFF_QNOPE); const bf16_t* Qr = (const bf16_t*)P.out + 1024; const bf16_t* Kn = (const bf16_t*)(ws + OFF_KNOPE); const bf16_t* Kr = (const bf16_t*)(ws + OFF_KROPE); const bf16_t* Vt = (const bf16_t*)(ws + OFF_VT);
    LAS unsigned char* sK = lds; LAS unsigned char* sV = lds + 25600;
    constexpr int ABUF = 44032;
    const int tid = tid_opaque(), wid = __builtin_amdgcn_readfirstlane(tid >> 6), lane = tid & 63, l32 = lane & 31, hi = lane >> 5;
    for (int u = blockIdx.x; u < 1024; u += gridDim.x) {
        const int j4 = u >> 8, cc = u & 255, xq = cc & 7, iq = cc >> 3, bh = 4 * xq + j4;
        const int qb = (j4 & 1) ? 31 - iq : iq;
        const int b = bh >> 4, h = bh & 15;
        const int q0 = qb * 256 + wid * 32; const int qi = q0 + l32; const size_t qrow = (size_t)b * S_ + qi;
        bf16x8 qf[12];
#pragma unroll
        for (int ks = 0; ks < 8; ++ks) qf[ks] = *(const bf16x8*)(Qn + qrow * 2048 + h * 128 + ks * 16 + hi * 8);
#pragma unroll
        for (int ks = 0; ks < 4; ++ks) qf[8 + ks] = *(const bf16x8*)(Qr + qrow * 2048 + h * 64 + ks * 16 + hi * 8);
        f32x16 o[4];
#pragma unroll
        for (int d = 0; d < 4; ++d)
#pragma unroll
            for (int r = 0; r < 16; ++r) o[d][r] = 0.f;
        float mrun = -INFINITY, lsum = 0.f;
        const int ntiles = qb * 4 + 4;
        const int kn_key0 = tid >> 4, kn_ch = tid & 15;
        const int kr_key = tid >> 3, kr_ch = tid & 7;
        const int v_d0 = tid >> 3, v_ch = tid & 7;
        const bf16_t* gkn = Kn + ((size_t)bh * S_ + kn_key0) * 128 + kn_ch * 8;
        const bf16_t* gkr = Kr + ((size_t)b * S_ + kr_key) * 64 + kr_ch * 8;
        const bf16_t* gv = Vt + ((size_t)bh * 128 + v_d0) * S_ + v_ch * 8;
        u32x4 pk0, pk1, pkr, pv0, pv1;
        pk0 = *(const u32x4*)(gkn); pk1 = *(const u32x4*)(gkn + 32 * 128); pkr = *(const u32x4*)(gkr); pv0 = *(const u32x4*)(gv); pv1 = *(const u32x4*)(gv + (size_t)64 * S_);
        __syncthreads();
        *(LAS u32x4*)(sK + kn_key0 * 400 + kn_ch * 16) = pk0; *(LAS u32x4*)(sK + (kn_key0 + 32) * 400 + kn_ch * 16) = pk1; *(LAS u32x4*)(sK + kr_key * 400 + 256 + kr_ch * 16) = pkr;
        *(LAS u32x4*)(sV + v_d0 * 144 + v_ch * 16) = pv0; *(LAS u32x4*)(sV + (v_d0 + 64) * 144 + v_ch * 16) = pv1;
        __syncthreads();
        for (int kt = 0; kt < ntiles; ++kt) {
            const bool more = (kt + 1 < ntiles);
            const int cur = (kt & 1) * ABUF, nxt = ABUF - cur;
            if (more) { const size_t ko = (size_t)(kt + 1) * 64;
                pk0 = *(const u32x4*)(gkn + ko * 128); pk1 = *(const u32x4*)(gkn + (ko + 32) * 128); pkr = *(const u32x4*)(gkr + ko * 64); pv0 = *(const u32x4*)(gv + ko); pv1 = *(const u32x4*)(gv + (size_t)64 * S_ + ko); }
            const int kmin = kt * 64;
            if (kmin <= q0 + 31) {
                const LAS unsigned char* cK = sK + cur; const LAS unsigned char* cV = sV + cur;
                f32x16 s0, s1;
#pragma unroll
                for (int r = 0; r < 16; ++r) { s0[r] = 0.f; s1[r] = 0.f; }
                {
                    bf16x8 A0[4], A1[4], B0[4], B1[4];
#define LDK(D0, D1, K4) _Pragma("unroll") for (int kk2 = 0; kk2 < 4; ++kk2) { D0[kk2] = *(const LAS bf16x8*)(cK + l32 * 400 + ((K4) + kk2) * 32 + hi * 16); D1[kk2] = *(const LAS bf16x8*)(cK + (32 + l32) * 400 + ((K4) + kk2) * 32 + hi * 16); }
#define MMK(D0, D1, K4) _Pragma("unroll") for (int kk2 = 0; kk2 < 4; ++kk2) { s0 = __builtin_amdgcn_mfma_f32_32x32x16_bf16(D0[kk2], qf[(K4) + kk2], s0, 0, 0, 0); s1 = __builtin_amdgcn_mfma_f32_32x32x16_bf16(D1[kk2], qf[(K4) + kk2], s1, 0, 0, 0); }
                    LDK(A0, A1, 0) LDK(B0, B1, 4)
                    MMK(A0, A1, 0)
                    LDK(A0, A1, 8)
                    MMK(B0, B1, 4)
                    MMK(A0, A1, 8)
                    __builtin_amdgcn_sched_group_barrier(0x100, 6, 0);
#pragma unroll
                    for (int gI = 0; gI < 9; ++gI) { __builtin_amdgcn_sched_group_barrier(0x008, 2, 0); __builtin_amdgcn_sched_group_barrier(0x100, 2, 0); }
                    __builtin_amdgcn_sched_group_barrier(0x008, 6, 0);
#undef LDK
#undef MMK
                }
                if (kmin + 63 > q0) {
#pragma unroll
                    for (int r = 0; r < 16; ++r) { const int key = kmin + 8 * (r >> 2) + 4 * hi + (r & 3); if (key > qi) s0[r] = -INFINITY; if (key + 32 > qi) s1[r] = -INFINITY; }
                }
                float mx = s0[0];
#pragma unroll
                for (int r = 1; r < 16; ++r) mx = fmaxf(mx, s0[r]);
#pragma unroll
                for (int r = 0; r < 16; ++r) mx = fmaxf(mx, s1[r]);
                mx = fmaxf(mx, __shfl_xor(mx, 32));
                if (__builtin_amdgcn_ballot_w64(mx > mrun) != 0ull) {
                    const float mnew = fmaxf(mrun, mx); const float alpha = __builtin_amdgcn_exp2f(mrun - mnew); mrun = mnew;
                    lsum *= alpha;
#pragma unroll
                    for (int d = 0; d < 4; ++d)
#pragma unroll
                        for (int r = 0; r < 16; ++r) o[d][r] *= alpha;
                }
                float ps = 0.f;
#pragma unroll
                for (int r = 0; r < 16; ++r) { s0[r] = __builtin_amdgcn_exp2f(s0[r] - mrun); s1[r] = __builtin_amdgcn_exp2f(s1[r] - mrun); ps += s0[r] + s1[r]; }
                lsum += ps;
                bf16x8 pa[2][2];
#pragma unroll
                for (int t = 0; t < 2; ++t) {
                    u32x4 w0, w1;
                    w0.x = cvt_pk_bf16(s0[8 * t + 0], s0[8 * t + 1]); w0.y = cvt_pk_bf16(s0[8 * t + 2], s0[8 * t + 3]); w0.z = cvt_pk_bf16(s0[8 * t + 4], s0[8 * t + 5]); w0.w = cvt_pk_bf16(s0[8 * t + 6], s0[8 * t + 7]);
                    w1.x = cvt_pk_bf16(s1[8 * t + 0], s1[8 * t + 1]); w1.y = cvt_pk_bf16(s1[8 * t + 2], s1[8 * t + 3]); w1.z = cvt_pk_bf16(s1[8 * t + 4], s1[8 * t + 5]); w1.w = cvt_pk_bf16(s1[8 * t + 6], s1[8 * t + 7]);
                    pa[0][t] = __builtin_bit_cast(bf16x8, w0); pa[1][t] = __builtin_bit_cast(bf16x8, w1);
                }
                {
                    u32x4 Va[4], Vb[4];
#define LDV(D, G) _Pragma("unroll") for (int d = 0; d < 4; ++d) { D[d] = *(const LAS u32x4*)(cV + (d * 32 + l32) * 144 + (((G) >> 1) * 32 + ((G) & 1) * 16 + hi * 8) * 2); }
#define MMV(D, G) _Pragma("unroll") for (int d = 0; d < 4; ++d) o[d] = __builtin_amdgcn_mfma_f32_32x32x16_bf16(__builtin_bit_cast(bf16x8, D[d]), pa[(G) >> 1][(G) & 1], o[d], 0, 0, 0);
                    LDV(Va, 0) LDV(Vb, 1)
                    MMV(Va, 0)
                    LDV(Va, 2)
                    MMV(Vb, 1)
                    LDV(Vb, 3)
                    MMV(Va, 2)
                    MMV(Vb, 3)
                    __builtin_amdgcn_sched_group_barrier(0x100, 8, 1);
                    __builtin_amdgcn_sched_group_barrier(0x008, 4, 1); __builtin_amdgcn_sched_group_barrier(0x100, 4, 1);
                    __builtin_amdgcn_sched_group_barrier(0x008, 4, 1); __builtin_amdgcn_sched_group_barrier(0x100, 4, 1);
                    __builtin_amdgcn_sched_group_barrier(0x008, 8, 1);
#undef LDV
#undef MMV
                }
            }
            if (more) {
                *(LAS u32x4*)(sK + nxt + kn_key0 * 400 + kn_ch * 16) = pk0; *(LAS u32x4*)(sK + nxt + (kn_key0 + 32) * 400 + kn_ch * 16) = pk1; *(LAS u32x4*)(sK + nxt + kr_key * 400 + 256 + kr_ch * 16) = pkr;
                *(LAS u32x4*)(sV + nxt + v_d0 * 144 + v_ch * 16) = pv0; *(LAS u32x4*)(sV + nxt + (v_d0 + 64) * 144 + v_ch * 16) = pv1;
            }
            __syncthreads();
        }
        lsum += __shfl_xor(lsum, 32);
        const float inv = 1.0f / lsum;
        bf16_t* op = Qn + qrow * 2048 + h * 128;
        if (dummy) op = (bf16_t*)(ws + WS_NEED) + ((qrow * 2048 + h * 128) & (size_t)(4 * 1024 * 1024 - 1));
#pragma unroll
        for (int d = 0; d < 4; ++d)
#pragma unroll
            for (int r4 = 0; r4 < 4; ++r4) {
                u32x2 w; w.x = cvt_pk_bf16(o[d][4 * r4] * inv, o[d][4 * r4 + 1] * inv); w.y = cvt_pk_bf16(o[d][4 * r4 + 2] * inv, o[d][4 * r4 + 3] * inv);
                *(u32x2*)(op + d * 32 + 8 * r4 + 4 * hi) = w;
            }
    }
}

__device__ void final_phase(const KP& P) {
    float* X = P.out; const float* g = P.in[20]; const bf16_t* xhi = (const bf16_t*)(P.ws + OFF_XB2); const bf16_t* xlo = (const bf16_t*)P.out;
    const int tid = tid_opaque(); const int wid = tid >> 6, lane = tid & 63;
    for (int row = blockIdx.x * 8 + wid; row < T_; row += gridDim.x * 8) {
        f32x4 v[4]; float ss = 0.f;
#pragma unroll
        for (int i = 0; i < 4; ++i) { const u32x2 h = *(const u32x2*)(xhi + (size_t)row * D_ + i * 256 + lane * 4), l = *(const u32x2*)(xlo + (size_t)row * 2048 + i * 256 + lane * 4);
            v[i] = (f32x4){bflo(h.x) + bflo(l.x), bfhi(h.x) + bfhi(l.x), bflo(h.y) + bflo(l.y), bfhi(h.y) + bfhi(l.y)}; ss += (v[i][0] * v[i][0] + v[i][1] * v[i][1]) + (v[i][2] * v[i][2] + v[i][3] * v[i][3]); }
#pragma unroll
        for (int o = 32; o > 0; o >>= 1) ss += __shfl_xor(ss, o);
        const float rs = rsqrtf(ss * (1.0f / 1024.0f) + EPS_);
#pragma unroll
        for (int i = 0; i < 4; ++i) { const f32x4 gg = *(const f32x4*)(g + i * 256 + lane * 4); *(f32x4*)(X + (size_t)row * D_ + i * 256 + lane * 4) = v[i] * rs * gg; }
    }
}

constexpr size_t OFF_BAR = OFF_LB + 65536;
__device__ __forceinline__ unsigned xcc_id() { return (unsigned)__builtin_amdgcn_s_getreg((3 << 11) | 20) & 0xFu; }
__device__ __forceinline__ void gbar(unsigned* bar, unsigned k, unsigned x, unsigned gsize, unsigned nx) {
    asm volatile("s_waitcnt vmcnt(0)" ::: "memory");
    __syncthreads();
    if (threadIdx.x == 0) {
        const unsigned old = __hip_atomic_fetch_add(bar + 64 * (16 + x), 1u, __ATOMIC_RELAXED, __HIP_MEMORY_SCOPE_AGENT);
        if (old + 1u == k * gsize) {
            __builtin_amdgcn_fence(__ATOMIC_RELEASE, "agent");
            asm volatile("s_waitcnt vmcnt(0)" ::: "memory");
            const unsigned old2 = __hip_atomic_fetch_add(bar + 64 * 32, 1u, __ATOMIC_RELAXED, __HIP_MEMORY_SCOPE_AGENT);
            if (old2 + 1u == k * nx) { for (unsigned j = 0; j < 16; ++j) __hip_atomic_store(bar + 64 * (33 + j), k, __ATOMIC_RELAXED, __HIP_MEMORY_SCOPE_AGENT); }
        }
        unsigned spins = 0;
        while (__hip_atomic_load(bar + 64 * (33 + x), __ATOMIC_RELAXED, __HIP_MEMORY_SCOPE_AGENT) < k && ++spins < (1u << 24)) __builtin_amdgcn_s_sleep(1);
        __builtin_amdgcn_fence(__ATOMIC_ACQUIRE, "agent");
        asm volatile("s_waitcnt vmcnt(0)" ::: "memory");
    }
    __syncthreads();
}
enum { PH_PREP = 0, PH_GEMM = 1, PH_HA = 2, PH_HB = 3, PH_HC = 4, PH_ATTN = 5, PH_FINAL = 6 };
constexpr int N_PHASES = 21;

__device__ __forceinline__ GemmJob mk(const void* A, const void* Bt, int N, int K, int epi, int rot) {
    GemmJob j; j.A = (const bf16_t*)A; j.Bt = (const bf16_t*)Bt; j.M = T_; j.N = N; j.K = K; j.epi = epi; j.rot = rot; j.ssq = nullptr; j.np = 16; j.invdim = 1.0f / 1024.0f;
    j.o0 = j.o1 = j.o2 = j.o3 = nullptr; j.i0 = j.i1 = nullptr; j.f0 = 1.0f; return j;
}
__device__ __forceinline__ int get_phase(const KP& P, int ph, GemmJob& j0, GemmJob& j1, int& nj) {
    unsigned char* ws = P.ws; nj = 1;
    const float* ssq0 = (const float*)(ws + OFF_SSQ0); const float* ssq1 = (const float*)(ws + OFF_SSQ1);
    auto ffn1 = [&](int l, int jj, const float* ssq) { GemmJob j = mk(ws + OFF_XB, ws + OFF_FI + (size_t)(l * 2 + jj) * SZ_FI, 2 * FF_, D_, EPI_SWIGLU, 0); j.ssq = ssq; j.o0 = ws + OFF_ACT; return j; };
    auto resid = [&](const void* A, const void* Bt, int K, float sc, size_t srchi, size_t ssqo) { GemmJob j = mk(A, Bt, D_, K, EPI_RESID, 0); j.o0 = P.out; j.o1 = ws + OFF_XB; j.o2 = ws + ssqo; j.i0 = ws + srchi; j.f0 = sc; return j; };
    auto pej = [&](int l) { GemmJob j = mk(ws + OFF_PB + (size_t)l * T_ * 256 * 2, ws + OFF_PI + (size_t)l * (MiB / 2), D_, 256, EPI_BF16, 0); j.o0 = ws + OFF_PE; return j; };
    auto plej = [&](int l) { GemmJob j = mk(ws + OFF_XB, ws + OFF_PG + (size_t)l * 2 * MiB, D_, D_, EPI_PLE, 0); j.ssq = ssq1; j.o0 = P.out; j.o1 = ws + OFF_XB2; j.o2 = ws + OFF_SSQ0; j.i0 = ws + OFF_XB; j.i1 = ws + OFF_PE; return j; };
    switch (ph) {
    case 0: return PH_PREP;
    case 1: j0 = ffn1(0, 0, ssq0); return PH_GEMM;
    case 2: j0 = resid(ws + OFF_ACT, ws + OFF_FO + 0 * SZ_FO, FF_, 0.5f, OFF_XB, OFF_SSQ1); return PH_GEMM;
    case 3: { j0 = mk(ws + OFF_XB, ws + OFF_AIN, 4096, D_, EPI_HGRN, 0); j0.ssq = ssq1; j0.o0 = ws + OFF_HQ; j0.o1 = ws + OFF_HKK; j0.o2 = ws + OFF_HV; j0.o3 = ws + OFF_HOG; j0.i0 = ws + OFF_LB; return PH_GEMM; }
    case 4: return PH_HA;
    case 5: return PH_HB;
    case 6: return PH_HC;
    case 7: j0 = resid(ws + OFF_HQ, ws + OFF_AOUT, D_, 1.0f, OFF_XB, OFF_SSQ0); return PH_GEMM;
    case 8: j0 = ffn1(0, 1, ssq0); j1 = pej(0); j1.rot = 128; nj = 2; return PH_GEMM;
    case 9: j0 = resid(ws + OFF_ACT, ws + OFF_FO + 1 * SZ_FO, FF_, 0.5f, OFF_XB, OFF_SSQ1); return PH_GEMM;
    case 10: j0 = plej(0); return PH_GEMM;
    case 11: { j0 = ffn1(1, 0, ssq0); j0.A = (const bf16_t*)(ws + OFF_XB2); j1 = mk(ws + OFF_XB2, ws + OFF_KVD, 512, D_, EPI_KVDOWN, 128); j1.ssq = ssq0; j1.o0 = ws + OFF_CKV; j1.o1 = ws + OFF_SSQCKV; j1.o2 = ws + OFF_KROPE; j1.i0 = ws + OFF_ROPE; nj = 2; return PH_GEMM; }
    case 12: j0 = resid(ws + OFF_ACT, ws + OFF_FO + 2 * SZ_FO, FF_, 0.5f, OFF_XB2, OFF_SSQ1); return PH_GEMM;
    case 13: { j0 = mk(ws + OFF_XB, ws + OFF_DQ, 512, D_, EPI_CQ, 0); j0.ssq = ssq1; j0.o0 = ws + OFF_CQ; j0.o1 = ws + OFF_SSQCQ;
               j1 = mk(ws + OFF_CKV, ws + OFF_KVU, 4096, 256, EPI_KVUP, 128); j1.ssq = (const float*)(ws + OFF_SSQCKV); j1.np = 4; j1.invdim = 1.0f / 256.0f; j1.o0 = ws + OFF_KNOPE; j1.o1 = ws + OFF_VT; nj = 2; return PH_GEMM; }
    case 14: { j0 = mk(ws + OFF_CQ, ws + OFF_UQ, 3072, 512, EPI_QUP, 0); j0.ssq = (const float*)(ws + OFF_SSQCQ); j0.np = 8; j0.invdim = 1.0f / 512.0f; j0.o0 = ws + OFF_QNOPE; j0.o1 = (bf16_t*)P.out + 1024; j0.i0 = ws + OFF_ROPE;
               j0.f0 = 0.07216878364870322f * 1.4426950408889634f; return PH_GEMM; }
    case 15: return PH_ATTN;
    case 16: j0 = resid(ws + OFF_QNOPE, ws + OFF_BO, 2048, 1.0f, OFF_XB, OFF_SSQ0); return PH_GEMM;
    case 17: j0 = ffn1(1, 1, ssq0); j1 = pej(1); j1.rot = 128; nj = 2; return PH_GEMM;
    case 18: j0 = resid(ws + OFF_ACT, ws + OFF_FO + 3 * SZ_FO, FF_, 0.5f, OFF_XB, OFF_SSQ1); return PH_GEMM;
    case 19: j0 = plej(1); return PH_GEMM;
    default: return PH_FINAL;
    }
}

constexpr int TAB_OFF = 132096, TAB_SLOT = 320;
static_assert(sizeof(GemmJob) <= 152 && TAB_OFF + N_PHASES * TAB_SLOT <= LDS_BYTES, "phase table");
__global__ void __launch_bounds__(512, 2) yoco_fwd(KP P, int ph_lo, int ph_hi) {
    extern __shared__ __attribute__((aligned(16))) unsigned char smem_raw[];
    LAS unsigned char* lds = (LAS unsigned char*)smem_raw;
    cg::grid_group grid = cg::this_grid();
    if (threadIdx.x < N_PHASES) {
        GemmJob j0 = mk(nullptr, nullptr, 256, 256, 0, 0), j1 = j0; int nj = 1;
        const int kind = get_phase(P, threadIdx.x, j0, j1, nj);
        LAS unsigned char* slot = lds + TAB_OFF + threadIdx.x * TAB_SLOT;
        *(LAS int*)slot = kind; *(LAS int*)(slot + 4) = nj;
        { const unsigned* s0 = (const unsigned*)&j0; const unsigned* s1 = (const unsigned*)&j1;
#pragma unroll
          for (int w = 0; w < (int)(sizeof(GemmJob) / 4); ++w) { *(LAS unsigned*)(slot + 16 + 4 * w) = s0[w]; *(LAS unsigned*)(slot + 16 + 152 + 4 * w) = s1[w]; } }
    }
    __syncthreads();
    if (threadIdx.x == 0) __hip_atomic_fetch_add((unsigned*)(P.ws + OFF_BAR) + 64 * xcc_id(), 1u, __ATOMIC_RELAXED, __HIP_MEMORY_SCOPE_AGENT);
    for (int ph = ph_lo; ph < ph_hi; ++ph) {
        const LAS unsigned char* slot = lds + TAB_OFF + ph * TAB_SLOT;
        const int kind = __builtin_amdgcn_readfirstlane(*(const LAS int*)slot), nj = __builtin_amdgcn_readfirstlane(*(const LAS int*)(slot + 4));
        if (kind == PH_GEMM) {
            for (int ji = 0; ji < nj; ++ji) {
                const LAS GemmJob* J = (const LAS GemmJob*)(slot + 16 + ji * 152);
                Sched S; S.init(__builtin_amdgcn_readfirstlane(J->M), __builtin_amdgcn_readfirstlane(J->N), gridDim.x, blockIdx.x, __builtin_amdgcn_readfirstlane(J->rot));
                gemm_phase<true, true>(lds, J, S);
                __syncthreads();
            }
        } else if (kind == PH_PREP) prep_phase(P, lds);
        else if (kind == PH_HA) hgrn_a(P, lds);
        else if (kind == PH_HB) hgrn_b(P);
        else if (kind == PH_HC) hgrn_c(P, lds);
        else if (kind == PH_ATTN) {
            attn_phase(P, lds);
        }
        else final_phase(P);
        if (ph + 1 < ph_hi) {
            unsigned* bar = (unsigned*)(P.ws + OFF_BAR);
            if (ph == ph_lo) {
                grid.sync();
                if (threadIdx.x == 0) { const unsigned xcc = xcc_id(); unsigned n = 0, mine = 1;
                    for (int j = 0; j < 16; ++j) { const unsigned c = __hip_atomic_load(bar + 64 * j, __ATOMIC_RELAXED, __HIP_MEMORY_SCOPE_AGENT); n += (c > 0u); if ((unsigned)j == xcc) mine = c; }
                    *(LAS unsigned*)(lds + TAB_OFF - 16) = mine; *(LAS unsigned*)(lds + TAB_OFF - 12) = n; *(LAS unsigned*)(lds + TAB_OFF - 8) = xcc; }
                __syncthreads();
            } else gbar(bar, (unsigned)(ph - ph_lo), *(LAS unsigned*)(lds + TAB_OFF - 8), *(LAS unsigned*)(lds + TAB_OFF - 16), *(LAS unsigned*)(lds + TAB_OFF - 12));
        }
    }
}

extern "C" void kernel_launch(void* const* d_in, const int* in_sizes, int n_in, void* d_out, int out_size, void* d_ws, size_t ws_size, hipStream_t stream) {
    static int grid_blocks = 0;
    if (grid_blocks == 0) {
        if (n_in != 21 || ws_size < WS_NEED) { fprintf(stderr, "kernel_launch: unexpected inputs (%d) or workspace %zu < %zu\n", n_in, ws_size, (size_t)WS_NEED); grid_blocks = -1; return; }
        int dev = 0, cus = 0, per_cu = 0;
        (void)hipGetDevice(&dev); (void)hipDeviceGetAttribute(&cus, hipDeviceAttributeMultiprocessorCount, dev);
        if (hipFuncSetAttribute((const void*)yoco_fwd, hipFuncAttributeMaxDynamicSharedMemorySize, LDS_BYTES) != hipSuccess) { fprintf(stderr, "kernel_launch: hipFuncSetAttribute failed\n"); grid_blocks = -1; return; }
        if (hipOccupancyMaxActiveBlocksPerMultiprocessor(&per_cu, (const void*)yoco_fwd, 512, LDS_BYTES) != hipSuccess || per_cu < 1) { fprintf(stderr, "kernel_launch: occupancy query says %d\n", per_cu); per_cu = 1; }
        (void)hipGetLastError();
        grid_blocks = cus * 1;
        fprintf(stderr, "kernel_launch: cus %d per_cu %d grid %d\n", cus, per_cu, grid_blocks);
    }
    if (grid_blocks < 0) return;
    KP p{};
    for (int i = 0; i < 21; ++i) p.in[i] = (const float*)d_in[i];
    p.out = (float*)d_out; p.ws = (unsigned char*)d_ws;
    for (int f = 0; f < 32; ++f) { const float ex = (float)f / 32.0f; const float pw = (float)std::pow(10000.0, (double)ex); p.inv_freq[f] = 1.0f / pw; }
    (void)hipMemsetAsync((unsigned char*)d_ws + OFF_BAR, 0, 16384, stream);
    int lo = 0, hi = N_PHASES;
    void* args[] = {&p, &lo, &hi};
    hipError_t e = hipLaunchCooperativeKernel((const void*)yoco_fwd, dim3(grid_blocks), dim3(512), args, LDS_BYTES, stream);
    if (e != hipSuccess) fprintf(stderr, "cooperative launch failed: %s (grid %d)\n", hipGetErrorString(e), grid_blocks);
}
```

```cpp
#include <hip/hip_runtime.h>
#include <hip/hip_cooperative_groups.h>
#include <cstdio>
#include <cstdint>
#include <cmath>
namespace cg = cooperative_groups;

#define LAS __attribute__((address_space(3)))
typedef unsigned short bf16_t;
typedef short bf16x8 __attribute__((ext_vector_type(8)));
typedef short s16x4 __attribute__((ext_vector_type(4)));
typedef float f32x4 __attribute__((ext_vector_type(4)));
typedef float f32x2 __attribute__((ext_vector_type(2)));
typedef float f32x16 __attribute__((ext_vector_type(16)));
typedef unsigned u32x4 __attribute__((ext_vector_type(4)));
typedef unsigned u32x2 __attribute__((ext_vector_type(2)));

constexpr int T_ = 16384, S_ = 8192, D_ = 1024, FF_ = 2816;
constexpr float EPS_ = 1e-6f;
constexpr int LDS_BYTES = 147456;

constexpr size_t MiB = 1u << 20;
constexpr size_t SZ_FI = 5632ull * 1024 * 2, SZ_FO = 1024ull * 2816 * 2;
constexpr size_t OFF_FI = 0;
constexpr size_t OFF_FO = OFF_FI + 4 * SZ_FI;
constexpr size_t OFF_PG = OFF_FO + 4 * SZ_FO;
constexpr size_t OFF_PI = OFF_PG + 4 * MiB;
constexpr size_t OFF_AIN = OFF_PI + 1 * MiB;
constexpr size_t OFF_AOUT = OFF_AIN + 8 * MiB;
constexpr size_t OFF_KVD = OFF_AOUT + 2 * MiB;
constexpr size_t OFF_KVU = OFF_KVD + 1 * MiB;
constexpr size_t OFF_DQ = OFF_KVU + 2 * MiB;
constexpr size_t OFF_UQ = OFF_DQ + 1 * MiB;
constexpr size_t OFF_BO = OFF_UQ + 3 * MiB;
constexpr size_t OFF_SSQ0 = OFF_BO + 4 * MiB;
constexpr size_t OFF_SSQ1 = OFF_SSQ0 + 1 * MiB;
constexpr size_t OFF_SSQCKV = OFF_SSQ1 + 1 * MiB;
constexpr size_t OFF_SSQCQ = OFF_SSQCKV + MiB / 2;
constexpr size_t OFF_DEC = OFF_SSQCQ + MiB / 2;
constexpr size_t OFF_LB = OFF_DEC + 1 * MiB;
constexpr size_t OFF_ROPE = OFF_LB + 1 * MiB;
constexpr size_t OFF_PB = OFF_ROPE + 4 * MiB;
constexpr size_t OFF_XB = OFF_PB + 16 * MiB;
constexpr size_t OFF_POOL = OFF_XB + 32 * MiB;
constexpr size_t OFF_ACT = OFF_POOL;
constexpr size_t OFF_HQ = OFF_POOL;
constexpr size_t OFF_HV = OFF_POOL + 32 * MiB;
constexpr size_t OFF_HOG = OFF_POOL + 64 * MiB;
constexpr size_t OFF_HKK = OFF_POOL + 96 * MiB;
constexpr size_t OFF_HKN = OFF_POOL + 160 * MiB;
constexpr size_t OFF_PE = OFF_POOL + 96 * MiB;
constexpr size_t OFF_KNOPE = OFF_POOL;
constexpr size_t OFF_VT = OFF_POOL + 64 * MiB;
constexpr size_t OFF_QNOPE = OFF_POOL + 128 * MiB;
constexpr size_t OFF_CKV = OFF_POOL + 128 * MiB;
constexpr size_t OFF_XB2 = OFF_POOL + 160 * MiB;
constexpr size_t OFF_CQ = OFF_FI;
constexpr size_t OFF_KROPE = OFF_FI + 16 * MiB;
constexpr size_t WS_NEED = OFF_POOL + 192 * MiB;

struct KP { const float* in[21]; float* out; unsigned char* ws; float inv_freq[32]; };

__device__ __forceinline__ int tid_opaque() { int t = threadIdx.x; asm volatile("" : "+v"(t)); return t; }
typedef __bf16 bf16x2_t __attribute__((ext_vector_type(2)));
__device__ __forceinline__ unsigned cvt_pk_bf16(float lo, float hi) { const f32x2 v = {lo, hi}; const bf16x2_t b = __builtin_convertvector(v, bf16x2_t); return __builtin_bit_cast(unsigned, b); }
__device__ __forceinline__ float bf2f(unsigned short b) { return __uint_as_float(((unsigned)b) << 16); }
__device__ __forceinline__ float bflo(unsigned w) { return __uint_as_float(w << 16); }
__device__ __forceinline__ float bfhi(unsigned w) { return __uint_as_float(w & 0xffff0000u); }
__device__ __forceinline__ float frcp(float x) { return __builtin_amdgcn_rcpf(x); }
__device__ __forceinline__ float sigmoidf_(float x) { return frcp(1.0f + __expf(-x)); }
__device__ __forceinline__ u32x4 pack8(f32x4 a, f32x4 b) { u32x4 w; w.x = cvt_pk_bf16(a[0], a[1]); w.y = cvt_pk_bf16(a[2], a[3]); w.z = cvt_pk_bf16(b[0], b[1]); w.w = cvt_pk_bf16(b[2], b[3]); return w; }

constexpr int BM = 256, BK = 64, HALF = 128, HTB = HALF * BK * 2, STAGE_BYTES = 8 * HTB, NXCD = 8, WGM = 8;
__host__ __device__ __forceinline__ int lds_byte(int r, int c) { const int st = (r >> 4) * 2 + (c >> 5), rr = r & 15, cc = c & 31, ob = rr * 64 + cc * 2; return st * 1024 + (ob ^ (((ob >> 9) & 1) << 5)); }
__host__ __device__ __forceinline__ void stage_rc(int b, int& R, int& C) { const int st = b / 1024, sb = b % 1024, swz = sb ^ (((sb >> 9) & 1) << 5); R = (st >> 1) * 16 + swz / 64; C = (st & 1) * 32 + (swz % 64) / 2; }
__host__ __device__ __forceinline__ int perm32(int rho) { const int n = rho >> 4, i = rho & 15; return 8 * (i >> 2) + 4 * n + (i & 3); }

struct Unit { int pm, pn; };
enum { EPI_SWIGLU = 0, EPI_RESID = 1, EPI_PLE = 2, EPI_HGRN = 3, EPI_BF16 = 4, EPI_KVDOWN = 5, EPI_CQ = 6, EPI_KVUP = 7, EPI_QUP = 8 };
struct GemmJob {
    const bf16_t* A; const bf16_t* Bt; int M, N, K; int epi; int rot;
    const float* ssq; int np; float invdim;
    void* o0; void* o1; void* o2; void* o3; const void* i0; const void* i1; float f0;
};
struct Sched {
    int nM, nN, nwg, G, c;
    __device__ void init(int M, int N, int G_, int c_, int rot) { nM = M / BM; nN = N / BM; nwg = nM * nN; G = G_; c = (c_ + G_ - (rot % G_)) % G_; }
    __device__ bool next(int i, Unit& u) const {
        const long L = (long)i * G + c; if (L >= nwg) return false;
        int wgid = (int)L; { const int q = nwg / NXCD, r = nwg % NXCD, xcd = wgid % NXCD, off = wgid / NXCD; wgid = (xcd < r ? xcd * (q + 1) : r * (q + 1) + (xcd - r) * q) + off; }
        const int nig = WGM * nN, gid = wgid / nig, fm = gid * WGM, gsz = (nM - fm) < WGM ? (nM - fm) : WGM;
        u.pm = fm + ((wgid % nig) % gsz); u.pn = (wgid % nig) / gsz; return true;
    }
};

__device__ __forceinline__ float row_rstd(const float* ssq, int np, int row, float invdim) {
    const f32x4* p = (const f32x4*)(ssq + (size_t)row * np); float s = 0.f;
    for (int i = 0; i < (np >> 2); ++i) { const f32x4 v = p[i]; s += (v[0] + v[1]) + (v[2] + v[3]); }
    return rsqrtf(s * invdim + EPS_);
}
__device__ __forceinline__ float sumsq8(f32x4 a, f32x4 b) { return (a[0] * a[0] + a[1] * a[1]) + (a[2] * a[2] + a[3] * a[3]) + (b[0] * b[0] + b[1] * b[1]) + (b[2] * b[2] + b[3] * b[3]); }

__device__ __forceinline__ void epilogue(const f32x4 (&acc)[2][2][4][2], const LAS GemmJob* Jp, int pm, int pn, int wr, int wc, int fr, int fq) {
    const int rbase = pm * BM + wr * 64 + fr;
    const int cl = wc * 32 + 8 * fq;
    const LAS GemmJob& J = *Jp;
    const int epi = __builtin_amdgcn_readfirstlane(J.epi);
    float rs8[2][4];
    if (epi != EPI_RESID && epi != EPI_BF16) {
        const float* ssq = J.ssq; const int np = J.np; const float invdim = J.invdim;
        f32x4 pv[2][4];
#pragma unroll
        for (int ai = 0; ai < 2; ++ai)
#pragma unroll
            for (int m = 0; m < 4; ++m) { const int row = rbase + ai * HALF + m * 16; pv[ai][m] = (4 * fq < np) ? *(const f32x4*)(ssq + (size_t)row * np + 4 * fq) : (f32x4){0.f, 0.f, 0.f, 0.f}; }
#pragma unroll
        for (int ai = 0; ai < 2; ++ai)
#pragma unroll
            for (int m = 0; m < 4; ++m) { float t = (pv[ai][m][0] + pv[ai][m][1]) + (pv[ai][m][2] + pv[ai][m][3]); t += __shfl_xor(t, 16); t += __shfl_xor(t, 32); rs8[ai][m] = rsqrtf(t * invdim + EPS_); }
    } else {
#pragma unroll
        for (int ai = 0; ai < 2; ++ai)
#pragma unroll
            for (int m = 0; m < 4; ++m) rs8[ai][m] = 0.f;
    }
    switch (epi) {
    case EPI_SWIGLU: {
        bf16_t* act = (bf16_t*)J.o0;
#pragma unroll
        for (int ai = 0; ai < 2; ++ai)
#pragma unroll
            for (int m = 0; m < 4; ++m) {
                const int row = rbase + ai * HALF + m * 16; const float rs = rs8[ai][m];
                f32x4 h[2];
#pragma unroll
                for (int n = 0; n < 2; ++n)
#pragma unroll
                    for (int j = 0; j < 4; ++j) { const float g = acc[ai][0][m][n][j] * rs, u = acc[ai][1][m][n][j] * rs; h[n][j] = g * frcp(1.0f + __expf(-g)) * u; }
                *(u32x4*)(act + (size_t)row * FF_ + pn * 128 + cl) = pack8(h[0], h[1]);
            }
    } break;
    case EPI_RESID: case EPI_PLE: {
        bf16_t* xlo = (bf16_t*)J.o0; bf16_t* xbd = (bf16_t*)J.o1; float* ssqo = (float*)J.o2; const bf16_t* xbs = (const bf16_t*)J.i0; const bf16_t* pe = (const bf16_t*)J.i1;
        const bool ple = (epi == EPI_PLE); const float sc = J.f0;
#pragma unroll
        for (int ai = 0; ai < 2; ++ai)
#pragma unroll
        for (int mh = 0; mh < 2; ++mh) {
            u32x4 XH[2][2], XL[2][2];
#pragma unroll
            for (int mm = 0; mm < 2; ++mm)
#pragma unroll
                for (int bj = 0; bj < 2; ++bj) { const int row = rbase + ai * HALF + (2 * mh + mm) * 16; const int col = pn * BM + bj * HALF + cl; XH[mm][bj] = *(const u32x4*)(xbs + (size_t)row * D_ + col); XL[mm][bj] = *(const u32x4*)(xlo + (size_t)row * 2048 + col); }
#pragma unroll
            for (int mm = 0; mm < 2; ++mm) {
                const int m = 2 * mh + mm;
                const int row = rbase + ai * HALF + m * 16; const float rs = rs8[ai][m];
                float ss = 0.f;
#pragma unroll
                for (int bj = 0; bj < 2; ++bj) {
                    const int col = pn * BM + bj * HALF + cl; const size_t off = (size_t)row * D_ + col;
                    const u32x4 h = XH[mm][bj], l = XL[mm][bj];
                    f32x4 x0 = (f32x4){bflo(h.x) + bflo(l.x), bfhi(h.x) + bfhi(l.x), bflo(h.y) + bflo(l.y), bfhi(h.y) + bfhi(l.y)};
                    f32x4 x1 = (f32x4){bflo(h.z) + bflo(l.z), bfhi(h.z) + bfhi(l.z), bflo(h.w) + bflo(l.w), bfhi(h.w) + bfhi(l.w)};
                    f32x4 d0 = acc[ai][bj][m][0], d1 = acc[ai][bj][m][1];
                    if (ple) {
                        const u32x4 pw = *(const u32x4*)(pe + off);
                        d0[0] = sigmoidf_(d0[0] * rs) * bflo(pw.x); d0[1] = sigmoidf_(d0[1] * rs) * bfhi(pw.x); d0[2] = sigmoidf_(d0[2] * rs) * bflo(pw.y); d0[3] = sigmoidf_(d0[3] * rs) * bfhi(pw.y);
                        d1[0] = sigmoidf_(d1[0] * rs) * bflo(pw.z); d1[1] = sigmoidf_(d1[1] * rs) * bfhi(pw.z); d1[2] = sigmoidf_(d1[2] * rs) * bflo(pw.w); d1[3] = sigmoidf_(d1[3] * rs) * bfhi(pw.w);
                    } else { d0 = d0 * sc; d1 = d1 * sc; }
                    x0 = x0 + d0; x1 = x1 + d1;
                    const u32x4 nh = pack8(x0, x1);
                    const f32x4 r0 = (f32x4){x0[0] - bflo(nh.x), x0[1] - bfhi(nh.x), x0[2] - bflo(nh.y), x0[3] - bfhi(nh.y)};
                    const f32x4 r1 = (f32x4){x1[0] - bflo(nh.z), x1[1] - bfhi(nh.z), x1[2] - bflo(nh.w), x1[3] - bfhi(nh.w)};
                    *(u32x4*)(xbd + off) = nh;
                    *(u32x4*)(xlo + (size_t)row * 2048 + col) = pack8(r0, r1);
                    ss += sumsq8(x0, x1);
                }
                ss += __shfl_xor(ss, 16); ss += __shfl_xor(ss, 32);
                if (fq == 0) ssqo[(size_t)row * 16 + pn * 4 + wc] = ss;
            }
        }
    } break;
    case EPI_HGRN: {
        const int sec = pn >> 2; const float* lb = (const float*)J.i0;
#pragma unroll
        for (int ai = 0; ai < 2; ++ai)
#pragma unroll
            for (int m = 0; m < 4; ++m) {
                const int row = rbase + ai * HALF + m * 16; const float rs = rs8[ai][m];
#pragma unroll
                for (int bj = 0; bj < 2; ++bj) {
                    const int cs = (pn & 3) * BM + bj * HALF + cl; const size_t off = (size_t)row * D_ + cs;
                    f32x4 v0 = acc[ai][bj][m][0] * rs, v1 = acc[ai][bj][m][1] * rs;
                    if (sec == 0) { v0 = v0 * 0.08838834764831845f; v1 = v1 * 0.08838834764831845f; *(u32x4*)((bf16_t*)J.o0 + off) = pack8(v0, v1); }
                    else if (sec == 1) {
                        const f32x4 l0 = *(const f32x4*)(lb + cs), l1 = *(const f32x4*)(lb + cs + 4);
#pragma unroll
                        for (int j = 0; j < 4; ++j) { v0[j] = (1.0f - l0[j]) * frcp(1.0f + __expf(v0[j])); v1[j] = (1.0f - l1[j]) * frcp(1.0f + __expf(v1[j])); }
                        *(f32x4*)((float*)J.o1 + off) = v0; *(f32x4*)((float*)J.o1 + off + 4) = v1;
                    } else if (sec == 2) { *(u32x4*)((bf16_t*)J.o2 + off) = pack8(v0, v1); }
                    else {
#pragma unroll
                        for (int j = 0; j < 4; ++j) { v0[j] = sigmoidf_(v0[j]); v1[j] = sigmoidf_(v1[j]); }
                        *(u32x4*)((bf16_t*)J.o3 + off) = pack8(v0, v1);
                    }
                }
            }
    } break;
    case EPI_BF16: {
        bf16_t* o = (bf16_t*)J.o0;
#pragma unroll
        for (int ai = 0; ai < 2; ++ai)
#pragma unroll
            for (int m = 0; m < 4; ++m) {
                const int row = rbase + ai * HALF + m * 16;
#pragma unroll
                for (int bj = 0; bj < 2; ++bj) *(u32x4*)(o + (size_t)row * J.N + pn * BM + bj * HALF + cl) = pack8(acc[ai][bj][m][0], acc[ai][bj][m][1]);
            }
    } break;
    case EPI_CQ: {
        bf16_t* o = (bf16_t*)J.o0; float* so = (float*)J.o1;
#pragma unroll
        for (int ai = 0; ai < 2; ++ai)
#pragma unroll
            for (int m = 0; m < 4; ++m) {
                const int row = rbase + ai * HALF + m * 16; const float rs = rs8[ai][m]; float ss = 0.f;
#pragma unroll
                for (int bj = 0; bj < 2; ++bj) { const f32x4 v0 = acc[ai][bj][m][0] * rs, v1 = acc[ai][bj][m][1] * rs; *(u32x4*)(o + (size_t)row * 512 + pn * BM + bj * HALF + cl) = pack8(v0, v1); ss += sumsq8(v0, v1); }
                ss += __shfl_xor(ss, 16); ss += __shfl_xor(ss, 32);
                if (fq == 0) so[(size_t)row * 8 + pn * 4 + wc] = ss;
            }
    } break;
    case EPI_KVDOWN: {
        bf16_t* ckv = (bf16_t*)J.o0; float* so = (float*)J.o1; bf16_t* kr = (bf16_t*)J.o2; const f32x2* rope = (const f32x2*)J.i0;
        if (pn == 0) {
#pragma unroll
            for (int ai = 0; ai < 2; ++ai)
#pragma unroll
                for (int m = 0; m < 4; ++m) {
                    const int row = rbase + ai * HALF + m * 16; const float rs = rs8[ai][m]; float ss = 0.f;
#pragma unroll
                    for (int bj = 0; bj < 2; ++bj) { const f32x4 v0 = acc[ai][bj][m][0] * rs, v1 = acc[ai][bj][m][1] * rs; *(u32x4*)(ckv + (size_t)row * 256 + bj * HALF + cl) = pack8(v0, v1); ss += sumsq8(v0, v1); }
                    ss += __shfl_xor(ss, 16); ss += __shfl_xor(ss, 32);
                    if (fq == 0) so[(size_t)row * 4 + wc] = ss;
                }
        } else if (wc == 0) {
#pragma unroll
            for (int ai = 0; ai < 2; ++ai)
#pragma unroll
                for (int m = 0; m < 4; ++m) {
                    const int row = rbase + ai * HALF + m * 16; const float rs = rs8[ai][m];
                    f32x4 a[2], b[2];
#pragma unroll
                    for (int n = 0; n < 2; ++n)
#pragma unroll
                        for (int j = 0; j < 4; ++j) { const f32x2 cs = rope[(size_t)row * 32 + 8 * fq + 4 * n + j]; const float x1 = acc[ai][0][m][n][j] * rs, x2 = acc[ai][1][m][n][j] * rs; a[n][j] = x1 * cs.x - x2 * cs.y; b[n][j] = x2 * cs.x + x1 * cs.y; }
                    *(u32x4*)(kr + (size_t)row * 64 + 8 * fq) = pack8(a[0], a[1]); *(u32x4*)(kr + (size_t)row * 64 + 32 + 8 * fq) = pack8(b[0], b[1]);
                }
        }
    } break;
    case EPI_KVUP: {
        bf16_t* kn = (bf16_t*)J.o0; bf16_t* vt = (bf16_t*)J.o1;
#pragma unroll
        for (int ai = 0; ai < 2; ++ai)
#pragma unroll
            for (int m = 0; m < 4; ++m) {
                const int row = rbase + ai * HALF + m * 16; const float rs = rs8[ai][m];
                const int b = row >> 13, s = row & (S_ - 1); const size_t bh = (size_t)b * 16 + pn;
                *(u32x4*)(kn + (bh * S_ + s) * 128 + cl) = pack8(acc[ai][0][m][0] * rs, acc[ai][0][m][1] * rs);
                const u32x4 w = pack8(acc[ai][1][m][0] * rs, acc[ai][1][m][1] * rs);
                const int sp = (s & ~15) | (((s >> 2) & 1) << 3) | (((s >> 3) & 1) << 2) | (s & 3);
                bf16_t* vp = vt + (bh * 128 + cl) * S_ + sp;
                vp[0 * S_] = (bf16_t)(w.x & 0xffff); vp[1 * S_] = (bf16_t)(w.x >> 16); vp[2 * S_] = (bf16_t)(w.y & 0xffff); vp[3 * S_] = (bf16_t)(w.y >> 16);
                vp[4 * S_] = (bf16_t)(w.z & 0xffff); vp[5 * S_] = (bf16_t)(w.z >> 16); vp[6 * S_] = (bf16_t)(w.w & 0xffff); vp[7 * S_] = (bf16_t)(w.w >> 16);
            }
    } break;
    case EPI_QUP: {
        bf16_t* qn = (bf16_t*)J.o0; bf16_t* qr = (bf16_t*)J.o1; const f32x2* rope = (const f32x2*)J.i0;
#pragma unroll
        for (int ai = 0; ai < 2; ++ai)
#pragma unroll
            for (int m = 0; m < 4; ++m) {
                const int row = rbase + ai * HALF + m * 16; const float rs = rs8[ai][m] * J.f0;
                if (pn < 8) {
#pragma unroll
                    for (int bj = 0; bj < 2; ++bj) *(u32x4*)(qn + (size_t)row * 2048 + pn * BM + bj * HALF + cl) = pack8(acc[ai][bj][m][0] * rs, acc[ai][bj][m][1] * rs);
                } else {
                    const int head = 4 * (pn - 8) + wc; f32x4 a[2], b[2];
#pragma unroll
                    for (int n = 0; n < 2; ++n)
#pragma unroll
                        for (int j = 0; j < 4; ++j) { const f32x2 cs = rope[(size_t)row * 32 + 8 * fq + 4 * n + j]; const float x1 = acc[ai][0][m][n][j] * rs, x2 = acc[ai][1][m][n][j] * rs; a[n][j] = x1 * cs.x - x2 * cs.y; b[n][j] = x2 * cs.x + x1 * cs.y; }
                    *(u32x4*)(qr + (size_t)row * 2048 + head * 64 + 8 * fq) = pack8(a[0], a[1]); *(u32x4*)(qr + (size_t)row * 2048 + head * 64 + 32 + 8 * fq) = pack8(b[0], b[1]);
                }
            }
    } break;
    default: break;
    }
}

__device__ __forceinline__ const char* rfl_ptr(const void* p) { const unsigned long long v = (unsigned long long)p; const unsigned lo = __builtin_amdgcn_readfirstlane((unsigned)v), hi = __builtin_amdgcn_readfirstlane((unsigned)(v >> 32)); return (const char*)(((unsigned long long)hi << 32) | lo); }
template <bool ALIGN_EPI, bool SP2>
__device__ __forceinline__ void gemm_phase(LAS unsigned char* lds, const LAS GemmJob* g, const Sched& S) {
    const int tid = tid_opaque(), wid = __builtin_amdgcn_readfirstlane(tid >> 6), lane = tid & 63, wr = wid >> 2, wc = wid & 3, fr = lane & 15, fq = lane >> 4;
    const int K = __builtin_amdgcn_readfirstlane(g->K), nt = K / BK;
    const char* gA = rfl_ptr(g->A); const char* gB = rfl_ptr(g->Bt);
    unsigned voffA[2], voffB[2];
#pragma unroll
    for (int i = 0; i < 2; ++i) { int R, C; stage_rc(tid * 16 + i * 8192, R, C); const int Rb = (R & ~31) + perm32(R & 31);
        voffA[i] = (unsigned)(R * K + C) * 2u; voffB[i] = (unsigned)(Rb * K + C) * 2u; }
    const size_t kstep = (size_t)(BK * 2);
    const size_t hstep = (size_t)HALF * K * 2;
    const size_t tstep = 2 * hstep;
    const unsigned ldsw = (unsigned)wid * 1024u;
    const int aoff = lds_byte(wr * 64 + fr, fq * 8), boff = lds_byte(wc * 32 + fr, fq * 8);
#define PG8_SA(b, h) (((b) * 2 + (h)) * HTB)
#define PG8_SB(b, h) ((4 + (b) * 2 + (h)) * HTB)
#define PG8_STAGE(bufoff, gbase, voff) do { _Pragma("unroll") for (int _i = 0; _i < 2; ++_i) \
        __builtin_amdgcn_global_load_lds((const unsigned*)((const char*)(gbase) + (voff)[_i]), (LAS unsigned*)(lds + (bufoff) + ldsw + _i * 8192), 16, 0, 0); } while (0)
#define PG8_LDA(dst, b, h) do { _Pragma("unroll") for (int m = 0; m < 4; ++m) _Pragma("unroll") for (int k = 0; k < 2; ++k) dst[m][k] = *(const LAS bf16x8*)(lds + PG8_SA(b, h) + aoff + m * 2048 + k * 1024); } while (0)
#define PG8_LDB(dst, b, h) do { _Pragma("unroll") for (int n = 0; n < 2; ++n) _Pragma("unroll") for (int k = 0; k < 2; ++k) dst[n][k] = *(const LAS bf16x8*)(lds + PG8_SB(b, h) + boff + n * 2048 + k * 1024); } while (0)
#define PG8_MMA(ai, bj, At, Bt) do { __builtin_amdgcn_s_setprio(1); _Pragma("unroll") for (int m = 0; m < 4; ++m) _Pragma("unroll") for (int n = 0; n < 2; ++n) _Pragma("unroll") for (int k = 0; k < 2; ++k) \
        acc[ai][bj][m][n] = __builtin_amdgcn_mfma_f32_16x16x32_bf16(Bt[n][k], At[m][k], acc[ai][bj][m][n], 0, 0, 0); __builtin_amdgcn_s_setprio(0); } while (0)
#define PG8_WAIT_V(n) asm volatile("s_waitcnt vmcnt(" #n ")" ::: "memory")
#define PG8_WAIT_L(n) asm volatile("s_waitcnt lgkmcnt(" #n ")" ::: "memory")
#define PG8_BAR __builtin_amdgcn_s_barrier()
#define PG8_SCHED __builtin_amdgcn_sched_barrier(0)
    Unit cur, nxt; int ui = 0;
    if (!S.next(0, cur)) return;
    f32x4 acc[2][2][4][2];
#pragma unroll
    for (int a = 0; a < 2; ++a)
#pragma unroll
        for (int b = 0; b < 2; ++b)
#pragma unroll
            for (int m = 0; m < 4; ++m)
#pragma unroll
                for (int n = 0; n < 2; ++n) acc[a][b][m][n] = (f32x4){0.f, 0.f, 0.f, 0.f};
    bf16x8 At[4][2], B0[2][2], B1[2][2];
    const char* cA = gA + (size_t)cur.pm * tstep; const char* cB = gB + (size_t)cur.pn * tstep;
    if constexpr (SP2) {
        PG8_STAGE(PG8_SB(0, 0), cB, voffB); PG8_STAGE(PG8_SB(0, 1), cB + hstep, voffB); PG8_STAGE(PG8_SA(0, 0), cA, voffA); PG8_STAGE(PG8_SA(0, 1), cA + hstep, voffA);
        if (wr == 1) PG8_BAR;
        PG8_WAIT_V(2); PG8_BAR;
        PG8_STAGE(PG8_SB(1, 0), cB + kstep, voffB); PG8_STAGE(PG8_SA(1, 0), cA + kstep, voffA); PG8_STAGE(PG8_SB(1, 1), cB + hstep + kstep, voffB);
        PG8_WAIT_V(6); PG8_BAR;
    } else {
        PG8_STAGE(PG8_SB(0, 0), cB, voffB); PG8_STAGE(PG8_SA(0, 0), cA, voffA); PG8_STAGE(PG8_SB(0, 1), cB + hstep, voffB); PG8_STAGE(PG8_SA(0, 1), cA + hstep, voffA);
        if (wr == 1) PG8_BAR;
        PG8_WAIT_V(4); PG8_BAR;
        PG8_STAGE(PG8_SB(1, 0), cB + kstep, voffB); PG8_STAGE(PG8_SA(1, 0), cA + kstep, voffA); PG8_STAGE(PG8_SB(1, 1), cB + hstep + kstep, voffB);
        PG8_WAIT_V(6); PG8_BAR;
    }
    for (;;) {
        const bool has_next = S.next(ui + 1, nxt);
        const char* nA = has_next ? gA + (size_t)nxt.pm * tstep : cA; const char* nB = has_next ? gB + (size_t)nxt.pn * tstep : cB;
        for (int t = 0; t < nt; t += 2) {
            const bool last = (t == nt - 2);
            const char* a1 = cA + (size_t)(t + 1) * kstep;
            const char* a2 = last ? nA : cA + (size_t)(t + 2) * kstep; const char* b2 = last ? nB : cB + (size_t)(t + 2) * kstep;
            const char* a3 = a2 + kstep; const char* b3 = b2 + kstep;
            if constexpr (SP2) {
            PG8_LDB(B0, 0, 0); PG8_LDB(B1, 0, 1); PG8_SCHED; PG8_LDA(At, 0, 0); PG8_STAGE(PG8_SA(1, 1), a1 + hstep, voffA);
            PG8_WAIT_V(8); PG8_WAIT_L(0); PG8_BAR; PG8_MMA(0, 0, At, B0); PG8_MMA(0, 1, At, B1); PG8_BAR; PG8_SCHED;
            PG8_LDA(At, 0, 1); PG8_STAGE(PG8_SB(0, 0), b2, voffB); PG8_STAGE(PG8_SB(0, 1), b2 + hstep, voffB); PG8_STAGE(PG8_SA(0, 0), a2, voffA);
            PG8_WAIT_V(8); PG8_WAIT_L(0); PG8_BAR; PG8_MMA(1, 0, At, B0); PG8_MMA(1, 1, At, B1); PG8_BAR; PG8_SCHED;
            PG8_LDB(B0, 1, 0); PG8_LDB(B1, 1, 1); PG8_SCHED; PG8_LDA(At, 1, 0); PG8_STAGE(PG8_SA(0, 1), a2 + hstep, voffA);
            PG8_WAIT_V(8); PG8_WAIT_L(0); PG8_BAR; PG8_MMA(0, 0, At, B0); PG8_MMA(0, 1, At, B1); PG8_BAR; PG8_SCHED;
            PG8_LDA(At, 1, 1); PG8_STAGE(PG8_SB(1, 0), b3, voffB); PG8_STAGE(PG8_SB(1, 1), b3 + hstep, voffB); PG8_STAGE(PG8_SA(1, 0), a3, voffA);
            PG8_WAIT_V(8); PG8_WAIT_L(0); PG8_BAR; PG8_MMA(1, 0, At, B0); PG8_MMA(1, 1, At, B1); PG8_BAR; PG8_SCHED;
            } else {
            PG8_LDB(B0, 0, 0); PG8_SCHED; PG8_LDA(At, 0, 0); PG8_STAGE(PG8_SA(1, 1), a1 + hstep, voffA);
            PG8_WAIT_L(8); PG8_BAR; PG8_WAIT_L(0); PG8_MMA(0, 0, At, B0); PG8_BAR; PG8_SCHED;
            PG8_LDB(B1, 0, 1); PG8_STAGE(PG8_SB(0, 0), b2, voffB);
            PG8_BAR; PG8_WAIT_L(0); PG8_MMA(0, 1, At, B1); PG8_BAR;
            PG8_LDA(At, 0, 1); PG8_STAGE(PG8_SA(0, 0), a2, voffA);
            PG8_BAR; PG8_WAIT_L(0); PG8_MMA(1, 0, At, B0); PG8_BAR; PG8_SCHED;
            PG8_STAGE(PG8_SB(0, 1), b2 + hstep, voffB);
            PG8_WAIT_V(6); PG8_BAR; PG8_MMA(1, 1, At, B1); PG8_BAR;
            PG8_LDB(B0, 1, 0); PG8_SCHED; PG8_LDA(At, 1, 0); PG8_STAGE(PG8_SA(0, 1), a2 + hstep, voffA);
            PG8_WAIT_L(8); PG8_BAR; PG8_WAIT_L(0); PG8_MMA(0, 0, At, B0); PG8_BAR; PG8_SCHED;
            PG8_LDB(B1, 1, 1); PG8_STAGE(PG8_SB(1, 0), b3, voffB);
            PG8_BAR; PG8_WAIT_L(0); PG8_MMA(0, 1, At, B1); PG8_BAR;
            PG8_LDA(At, 1, 1); PG8_STAGE(PG8_SA(1, 0), a3, voffA);
            PG8_BAR; PG8_WAIT_L(0); PG8_MMA(1, 0, At, B0); PG8_BAR; PG8_SCHED;
            PG8_STAGE(PG8_SB(1, 1), b3 + hstep, voffB);
            PG8_WAIT_V(6); PG8_BAR; PG8_MMA(1, 1, At, B1); PG8_BAR;
            }
        }
        if constexpr (ALIGN_EPI) { if (wr == 0) PG8_BAR; }
        epilogue(acc, g, cur.pm, cur.pn, wr, wc, fr, fq);
        if (!has_next) break;
#pragma unroll
        for (int a = 0; a < 2; ++a)
#pragma unroll
            for (int b = 0; b < 2; ++b)
#pragma unroll
                for (int m = 0; m < 4; ++m)
#pragma unroll
                    for (int n = 0; n < 2; ++n) acc[a][b][m][n] = (f32x4){0.f, 0.f, 0.f, 0.f};
        cur = nxt; cA = nA; cB = nB; ++ui;
        if constexpr (ALIGN_EPI) { if (wr == 1) PG8_BAR; }
    }
    PG8_WAIT_V(0);
    if constexpr (!ALIGN_EPI) { if (wr == 0) PG8_BAR; }
    PG8_BAR;
#undef PG8_SA
#undef PG8_SB
#undef PG8_STAGE
#undef PG8_LDA
#undef PG8_LDB
#undef PG8_MMA
#undef PG8_WAIT_V
#undef PG8_WAIT_L
#undef PG8_BAR
#undef PG8_SCHED
}

struct TJob { const float* src; int ld, K, N; bf16_t* dst; const float* gain; int kind; };
__device__ __forceinline__ int wmap(int kind, int n) {
    if (kind == 0) return n;
    if (kind == 1) { const int pn = n >> 8, r = n & 255; return (r >> 7) * FF_ + pn * 128 + (r & 127); }
    if (kind == 2) { if (n < 256) return n; const int r = n - 256, half = r >> 7, rr = r & 127; return (r < 256 && rr < 32) ? 256 + half * 32 + rr : -1; }
    { if (n < 2048) return (n >> 7) * 192 + (n & 127); const int nn = n - 2048, t = nn >> 8, r = nn & 255, half = r >> 7, hl = (r & 127) >> 5, i = r & 31; return (4 * t + hl) * 192 + 128 + half * 32 + i; }
}
__device__ __forceinline__ TJob get_tjob(const KP& P, int j) {
    TJob t; unsigned char* ws = P.ws; t.gain = nullptr; t.kind = 0;
    if (j < 4) { const int l = j >> 1, jj = j & 1; t.src = P.in[4] + (size_t)j * D_ * 2 * FF_; t.ld = 2 * FF_; t.K = D_; t.N = 2 * FF_; t.dst = (bf16_t*)(ws + OFF_FI + j * SZ_FI); t.gain = P.in[3] + (l * 4 + (jj ? 2 : 0)) * D_; t.kind = 1; }
    else if (j < 8) { const int i = j - 4; t.src = P.in[5] + (size_t)i * FF_ * D_; t.ld = D_; t.K = FF_; t.N = D_; t.dst = (bf16_t*)(ws + OFF_FO + i * SZ_FO); }
    else if (j < 10) { const int l = j - 8; t.src = P.in[6] + (size_t)l * D_ * D_; t.ld = D_; t.K = D_; t.N = D_; t.dst = (bf16_t*)(ws + OFF_PG + l * 2 * MiB); t.gain = P.in[3] + (l * 4 + 3) * D_; }
    else if (j < 12) { const int l = j - 10; t.src = P.in[7] + (size_t)l * 256 * D_; t.ld = D_; t.K = 256; t.N = D_; t.dst = (bf16_t*)(ws + OFF_PI + l * (MiB / 2)); }
    else if (j == 12) { t.src = P.in[8]; t.ld = 4096; t.K = D_; t.N = 4096; t.dst = (bf16_t*)(ws + OFF_AIN); t.gain = P.in[3] + 1 * D_; }
    else if (j == 13) { t.src = P.in[11]; t.ld = D_; t.K = D_; t.N = D_; t.dst = (bf16_t*)(ws + OFF_AOUT); }
    else if (j == 14) { t.src = P.in[13]; t.ld = 320; t.K = D_; t.N = 512; t.dst = (bf16_t*)(ws + OFF_KVD); t.gain = P.in[12]; t.kind = 2; }
    else if (j == 15) { t.src = P.in[15]; t.ld = 4096; t.K = 256; t.N = 4096; t.dst = (bf16_t*)(ws + OFF_KVU); t.gain = P.in[14]; }
    else if (j == 16) { t.src = P.in[16]; t.ld = 512; t.K = D_; t.N = 512; t.dst = (bf16_t*)(ws + OFF_DQ); t.gain = P.in[3] + (4 + 1) * D_; }
    else if (j == 17) { t.src = P.in[18]; t.ld = 3072; t.K = 512; t.N = 3072; t.dst = (bf16_t*)(ws + OFF_UQ); t.gain = P.in[17]; t.kind = 3; }
    else { t.src = P.in[19]; t.ld = D_; t.K = 2048; t.N = D_; t.dst = (bf16_t*)(ws + OFF_BO); }
    return t;
}
constexpr int N_TJOBS = 19;

__device__ void prep_phase(const KP& P, LAS unsigned char* lds) {
    const int tid = tid_opaque(), wid = tid >> 6, lane = tid & 63;
    unsigned char* ws = P.ws;
    LAS bf16_t* tile = (LAS bf16_t*)lds;
    for (int j = 0; j < N_TJOBS; ++j) {
        const TJob tj = get_tjob(P, j);
        const int nkt = tj.K >> 7, ntiles = nkt * (tj.N >> 6);
        for (int t = (blockIdx.x + j * 37) % gridDim.x; t < ntiles; t += gridDim.x) {
            const int ntile = t / nkt, kt = t - ntile * nkt;
            const int nn = tid & 63, kr = tid >> 6;
            const int col = wmap(tj.kind, ntile * 64 + nn);
            float vals[16];
#pragma unroll
            for (int i = 0; i < 16; ++i) { const int k = kt * 128 + kr + 8 * i; vals[i] = (col >= 0) ? tj.src[(size_t)k * tj.ld + col] : 0.f; }
            if (tj.gain) {
#pragma unroll
                for (int i = 0; i < 16; ++i) vals[i] *= tj.gain[kt * 128 + kr + 8 * i];
            }
#pragma unroll
            for (int i = 0; i < 16; ++i) tile[nn * 136 + kr + 8 * i] = (bf16_t)(cvt_pk_bf16(vals[i], 0.f) & 0xffff);
            __syncthreads();
#pragma unroll
            for (int c2 = 0; c2 < 2; ++c2) { const int ci = tid + 512 * c2, r = ci >> 4, ch = ci & 15; const u32x4 w = *(const LAS u32x4*)(tile + r * 136 + ch * 8); *(u32x4*)(tj.dst + (size_t)(ntile * 64 + r) * tj.K + kt * 128 + ch * 8) = w; }
            __syncthreads();
        }
    }
    const int gtid = blockIdx.x * 512 + tid, gthreads = gridDim.x * 512;
    { const float* p = P.in[1]; bf16_t* pb = (bf16_t*)(ws + OFF_PB);
      for (int i = gtid; i < 2 * T_ * 256 / 4; i += gthreads) { const f32x4 v = *(const f32x4*)(p + (size_t)i * 4); u32x2 w; w.x = cvt_pk_bf16(v[0], v[1]); w.y = cvt_pk_bf16(v[2], v[3]); *(u32x2*)(pb + (size_t)i * 4) = w; } }
    { const float* x = P.in[0]; bf16_t* xb = (bf16_t*)(ws + OFF_XB); bf16_t* xlo = (bf16_t*)P.out; float* ssq = (float*)(ws + OFF_SSQ0);
      for (int row = blockIdx.x * 8 + wid; row < T_; row += gridDim.x * 8) {
          float ss = 0.f;
#pragma unroll
          for (int i = 0; i < 4; ++i) { const size_t off = (size_t)row * D_ + i * 256 + lane * 4; const f32x4 v = *(const f32x4*)(x + off); ss += (v[0] * v[0] + v[1] * v[1]) + (v[2] * v[2] + v[3] * v[3]); u32x2 w; w.x = cvt_pk_bf16(v[0], v[1]); w.y = cvt_pk_bf16(v[2], v[3]); *(u32x2*)(xb + off) = w;
              u32x2 l; l.x = cvt_pk_bf16(v[0] - bflo(w.x), v[1] - bfhi(w.x)); l.y = cvt_pk_bf16(v[2] - bflo(w.y), v[3] - bfhi(w.y)); *(u32x2*)(xlo + (size_t)row * 2048 + i * 256 + lane * 4) = l; }
#pragma unroll
          for (int o = 32; o > 0; o >>= 1) ss += __shfl_xor(ss, o);
          if (lane < 16) ssq[(size_t)row * 16 + lane] = (lane == 0) ? ss : 0.f;
      } }
    if (blockIdx.x == 0) { const float* lg = P.in[9]; float* lb = (float*)(ws + OFF_LB); for (int i = tid; i < 1024; i += 512) lb[i] = 1.0f / (1.0f + expf(lg[1024 + i] - lg[i])); }
    { const int* pos = (const int*)P.in[2]; f32x2* rope = (f32x2*)(ws + OFF_ROPE);
      for (int i = gtid; i < T_ * 32; i += gthreads) {
          const int row = i >> 5, f = i & 31;
          const float inv = P.inv_freq[f];
          const float ang = (float)pos[row] * inv;
          const double a = (double)ang; const double k = rint(a * 0.15915494309189535); double r = fma(-k, 6.283185307179586, a); r = fma(-k, 2.4492935982947064e-16, r);
          const float rf = (float)r; f32x2 cs; cs.x = cosf(rf); cs.y = sinf(rf); rope[i] = cs;
      } }
}

__device__ __forceinline__ size_t u_byte(int row0, int h, int vd) { return ((size_t)(row0 + (vd >> 1)) * D_ + h * 128) * 4 + (vd & 1) * 256; }

__device__ void hgrn_a(const KP& P, LAS unsigned char* lds) {
    unsigned char* ws = P.ws;
    bf16_t* q = (bf16_t*)(ws + OFF_HQ); float* kk = (float*)(ws + OFF_HKK); unsigned char* kkb = ws + OFF_HKK; const bf16_t* v = (const bf16_t*)(ws + OFF_HV); bf16_t* Kn = (bf16_t*)(ws + OFF_HKN); float* dec = (float*)(ws + OFF_DEC);
    LAS bf16_t* sKl = (LAS bf16_t*)lds; LAS bf16_t* sVt = (LAS bf16_t*)(lds + 18432); LAS float* tot = (LAS float*)(lds + 36864);
    const int tid = tid_opaque(), wid = tid >> 6, lane = tid & 63, fr = lane & 15, fq = lane >> 4;
    const int k = tid & 127, rg = tid >> 7;
    for (int u = blockIdx.x; u < 2048; u += gridDim.x) {
        const int bh = u >> 7, c = u & 127, b = bh >> 3, h = bh & 7;
        const int row0 = b * S_ + c * 64; const size_t base = (size_t)(row0 + rg * 16) * D_ + h * 128 + k;
        float kv[16], bb[16]; float run = 0.f; unsigned short qraw[16], vraw[16];
#pragma unroll
        for (int r = 0; r < 16; ++r) kv[r] = kk[base + (size_t)r * D_];
#pragma unroll
        for (int r = 0; r < 16; ++r) { qraw[r] = q[base + (size_t)r * D_]; vraw[r] = v[base + (size_t)r * D_]; }
#pragma unroll
        for (int r = 0; r < 16; ++r) { run += __logf(1.0f - kv[r]); bb[r] = run; }
        tot[rg * 128 + k] = run;
        __syncthreads();
        float pre = 0.f, total = 0.f;
#pragma unroll
        for (int g = 0; g < 4; ++g) { const float t = tot[g * 128 + k]; if (g < rg) pre += t; total += t; }
        unsigned klp[8], vtp[8];
#pragma unroll
        for (int r = 0; r < 16; r += 2) {
            const float b0 = bb[r] + pre, b1 = bb[r + 1] + pre;
            const float q0 = bf2f(qraw[r]) * __expf(b0), q1 = bf2f(qraw[r + 1]) * __expf(b1);
            q[base + (size_t)r * D_] = (bf16_t)(cvt_pk_bf16(q0, 0.f) & 0xffff); q[base + (size_t)(r + 1) * D_] = (bf16_t)(cvt_pk_bf16(q1, 0.f) & 0xffff);
            const float n0 = kv[r] * __expf(-b0), n1 = kv[r + 1] * __expf(-b1);
            Kn[base + (size_t)r * D_] = (bf16_t)(cvt_pk_bf16(n0, 0.f) & 0xffff); Kn[base + (size_t)(r + 1) * D_] = (bf16_t)(cvt_pk_bf16(n1, 0.f) & 0xffff);
            klp[r >> 1] = cvt_pk_bf16(kv[r] * __expf(total - b0), kv[r + 1] * __expf(total - b1));
            vtp[r >> 1] = (unsigned)vraw[r] | ((unsigned)vraw[r + 1] << 16);
        }
        *(LAS u32x4*)(sKl + k * 72 + rg * 16) = (u32x4){klp[0], klp[1], klp[2], klp[3]}; *(LAS u32x4*)(sKl + k * 72 + rg * 16 + 8) = (u32x4){klp[4], klp[5], klp[6], klp[7]};
        *(LAS u32x4*)(sVt + k * 72 + rg * 16) = (u32x4){vtp[0], vtp[1], vtp[2], vtp[3]}; *(LAS u32x4*)(sVt + k * 72 + rg * 16 + 8) = (u32x4){vtp[4], vtp[5], vtp[6], vtp[7]};
        if (rg == 0) dec[(size_t)u * 128 + k] = __expf(total);
        __syncthreads();
        const int vb = wid * 16;
        bf16x8 bfr[2];
#pragma unroll
        for (int ks = 0; ks < 2; ++ks) bfr[ks] = *(const LAS bf16x8*)(sVt + (vb + fr) * 72 + ks * 32 + fq * 8);
#pragma unroll
        for (int kb = 0; kb < 8; ++kb) {
            f32x4 a4 = (f32x4){0.f, 0.f, 0.f, 0.f};
#pragma unroll
            for (int ks = 0; ks < 2; ++ks) { const bf16x8 afr = *(const LAS bf16x8*)(sKl + (kb * 16 + fr) * 72 + ks * 32 + fq * 8); a4 = __builtin_amdgcn_mfma_f32_16x16x32_bf16(afr, bfr[ks], a4, 0, 0, 0); }
            u32x2 w; w.x = cvt_pk_bf16(a4[0], a4[1]); w.y = cvt_pk_bf16(a4[2], a4[3]);
                        *(u32x2*)(kkb + u_byte(row0, h, vb + fr) + (kb * 16 + fq * 4) * 2) = w;
        }
        __syncthreads();
    }
}

__device__ void hgrn_b(const KP& P) {
    unsigned char* ws = P.ws; unsigned char* kkb = ws + OFF_HKK; const float* dec = (const float*)(ws + OFF_DEC);
    const int tid = tid_opaque();
    for (int item = blockIdx.x * 512 + tid; item < 16 * 8192; item += gridDim.x * 512) {
        const int bh = item >> 13, e2 = item & 8191, vd = e2 >> 6, k2 = (e2 & 63) * 2, b = bh >> 3, h = bh & 7;
        float s0 = 0.f, s1 = 0.f;
        for (int c0 = 0; c0 < 128; c0 += 16) {
            unsigned uu[16]; f32x2 dd[16];
#pragma unroll
            for (int i = 0; i < 16; ++i) { const int c = c0 + i; uu[i] = *(const unsigned*)(kkb + u_byte(b * S_ + c * 64, h, vd) + k2 * 2); dd[i] = *(const f32x2*)(dec + (size_t)(bh * 128 + c) * 128 + k2); }
#pragma unroll
            for (int i = 0; i < 16; ++i) { const int c = c0 + i; *(unsigned*)(kkb + u_byte(b * S_ + c * 64, h, vd) + k2 * 2) = cvt_pk_bf16(s0, s1); s0 = dd[i].x * s0 + bflo(uu[i]); s1 = dd[i].y * s1 + bfhi(uu[i]); }
        }
    }
}

__device__ void hgrn_c(const KP& P, LAS unsigned char* lds) {
    unsigned char* ws = P.ws;
    bf16_t* q = (bf16_t*)(ws + OFF_HQ); unsigned char* kkb = ws + OFF_HKK; const bf16_t* v = (const bf16_t*)(ws + OFF_HV); const bf16_t* Kn = (const bf16_t*)(ws + OFF_HKN); const bf16_t* og = (const bf16_t*)(ws + OFF_HOG);
    const float* gain = P.in[10];
    LAS bf16_t* sQ = (LAS bf16_t*)lds; LAS bf16_t* sK = (LAS bf16_t*)(lds + 17408); LAS bf16_t* sVt = (LAS bf16_t*)(lds + 34816); LAS bf16_t* sS = (LAS bf16_t*)(lds + 53248); LAS bf16_t* sP = (LAS bf16_t*)(lds + 88064); LAS float* red = (LAS float*)(lds + 97280);
    const int tid = tid_opaque(), wid = tid >> 6, lane = tid & 63, fr = lane & 15, fq = lane >> 4;
    for (int u = blockIdx.x; u < 2048; u += gridDim.x) {
        const int bh = u >> 7, c = u & 127, b = bh >> 3, h = bh & 7; const int row0 = b * S_ + c * 64;
#pragma unroll
        for (int i = 0; i < 2; ++i) { const int ci = tid + 512 * i, r = ci >> 4, ch = ci & 15; const size_t g = (size_t)(row0 + r) * D_ + h * 128 + ch * 8;
            *(LAS u32x4*)(sQ + r * 136 + ch * 8) = *(const u32x4*)(q + g); *(LAS u32x4*)(sK + r * 136 + ch * 8) = *(const u32x4*)(Kn + g); }
#pragma unroll
        for (int i = 0; i < 4; ++i) { const int ci = tid + 512 * i, vd = ci >> 4, ch = ci & 15; *(LAS u32x4*)(sS + vd * 136 + ch * 8) = *(const u32x4*)(kkb + u_byte(row0, h, vd) + ch * 16); }
        { const int k = tid & 127, rg = tid >> 7; const size_t base = (size_t)(row0 + rg * 16) * D_ + h * 128 + k; unsigned vtp[8];
#pragma unroll
          for (int r = 0; r < 16; r += 2) vtp[r >> 1] = (unsigned)v[base + (size_t)r * D_] | ((unsigned)v[base + (size_t)(r + 1) * D_] << 16);
          *(LAS u32x4*)(sVt + k * 72 + rg * 16) = (u32x4){vtp[0], vtp[1], vtp[2], vtp[3]}; *(LAS u32x4*)(sVt + k * 72 + rg * 16 + 8) = (u32x4){vtp[4], vtp[5], vtp[6], vtp[7]}; }
        const int tb = (wid >> 1) * 16, wh = wid & 1;
        u32x2 ogw[4]; f32x4 gnv[4];
#pragma unroll
        for (int j = 0; j < 4; ++j) { const int vd0 = wh * 64 + j * 16 + 4 * fq; ogw[j] = *(const u32x2*)(og + (size_t)(row0 + tb + fr) * D_ + h * 128 + vd0); gnv[j] = *(const f32x4*)(gain + vd0); }
        __syncthreads();
        bf16x8 bq[4];
#pragma unroll
        for (int ks = 0; ks < 4; ++ks) bq[ks] = *(const LAS bf16x8*)(sQ + (tb + fr) * 136 + ks * 32 + fq * 8);
#pragma unroll
        for (int j = 0; j < 2; ++j) {
            const int sb = (wh * 2 + j) * 16; f32x4 a4 = (f32x4){0.f, 0.f, 0.f, 0.f};
#pragma unroll
            for (int ks = 0; ks < 4; ++ks) { const bf16x8 a = *(const LAS bf16x8*)(sK + (sb + fr) * 136 + ks * 32 + fq * 8); a4 = __builtin_amdgcn_mfma_f32_16x16x32_bf16(a, bq[ks], a4, 0, 0, 0); }
            const int t = tb + fr, s0 = sb + 4 * fq;
#pragma unroll
            for (int e = 0; e < 4; ++e) if (s0 + e > t) a4[e] = 0.f;
            u32x2 w; w.x = cvt_pk_bf16(a4[0], a4[1]); w.y = cvt_pk_bf16(a4[2], a4[3]);
            *(LAS u32x2*)(sP + t * 72 + s0) = w;
        }
        __syncthreads();
        bf16x8 bp[2];
#pragma unroll
        for (int ks = 0; ks < 2; ++ks) bp[ks] = *(const LAS bf16x8*)(sP + (tb + fr) * 72 + ks * 32 + fq * 8);
        f32x4 o[4]; float ss = 0.f;
#pragma unroll
        for (int j = 0; j < 4; ++j) {
            const int vb = wh * 64 + j * 16; f32x4 a4 = (f32x4){0.f, 0.f, 0.f, 0.f};
#pragma unroll
            for (int ks = 0; ks < 4; ++ks) { const bf16x8 a = *(const LAS bf16x8*)(sS + (vb + fr) * 136 + ks * 32 + fq * 8); a4 = __builtin_amdgcn_mfma_f32_16x16x32_bf16(a, bq[ks], a4, 0, 0, 0); }
#pragma unroll
            for (int ks = 0; ks < 2; ++ks) { const bf16x8 a = *(const LAS bf16x8*)(sVt + (vb + fr) * 72 + ks * 32 + fq * 8); a4 = __builtin_amdgcn_mfma_f32_16x16x32_bf16(a, bp[ks], a4, 0, 0, 0); }
            o[j] = a4; ss += (a4[0] * a4[0] + a4[1] * a4[1]) + (a4[2] * a4[2] + a4[3] * a4[3]);
        }
        ss += __shfl_xor(ss, 16); ss += __shfl_xor(ss, 32);
        if (fq == 0) red[(tb + fr) * 2 + wh] = ss;
        __syncthreads();
        const float rstd = rsqrtf((red[(tb + fr) * 2] + red[(tb + fr) * 2 + 1]) * (1.0f / 128.0f) + EPS_);
#pragma unroll
        for (int j = 0; j < 4; ++j) {
            const int vd0 = wh * 64 + j * 16 + 4 * fq; const size_t g = (size_t)(row0 + tb + fr) * D_ + h * 128 + vd0;
            const f32x4 gn = gnv[j]; const u32x2 ow = ogw[j];
            u32x2 w; w.x = cvt_pk_bf16(o[j][0] * rstd * gn[0] * bflo(ow.x), o[j][1] * rstd * gn[1] * bfhi(ow.x)); w.y = cvt_pk_bf16(o[j][2] * rstd * gn[2] * bflo(ow.y), o[j][3] * rstd * gn[3] * bfhi(ow.y));
            *(u32x2*)(q + g) = w;
        }
        __syncthreads();
    }
}

__device__ void attn_phase(const KP& P, LAS unsigned char* lds, bool dummy = false) {
    unsigned char* ws = P.ws;
    bf16_t* Qn = (bf16_t*)(ws + OFF_QNOPE); const bf16_t* Qr = (const bf16_t*)P.out + 1024; const bf16_t* Kn = (const bf16_t*)(ws + OFF_KNOPE); const bf16_t* Kr = (const bf16_t*)(ws + OFF_KROPE); const bf16_t* Vt = (const bf16_t*)(ws + OFF_VT);
    LAS unsigned char* sK = lds; LAS unsigned char* sV = lds + 25600;
    constexpr int ABUF = 44032;
    const int tid = tid_opaque(), wid = __builtin_amdgcn_readfirstlane(tid >> 6), lane = tid & 63, l32 = lane & 31, hi = lane >> 5;
    for (int u = blockIdx.x; u < 1024; u += gridDim.x) {
        const int j4 = u >> 8, cc = u & 255, xq = cc & 7, iq = cc >> 3, bh = 4 * xq + j4;
        const int qb = (j4 & 1) ? 31 - iq : iq;
        const int b = bh >> 4, h = bh & 15;
        const int q0 = qb * 256 + wid * 32; const int qi = q0 + l32; const size_t qrow = (size_t)b * S_ + qi;
        bf16x8 qf[12];
#pragma unroll
        for (int ks = 0; ks < 8; ++ks) qf[ks] = *(const bf16x8*)(Qn + qrow * 2048 + h * 128 + ks * 16 + hi * 8);
#pragma unroll
        for (int ks = 0; ks < 4; ++ks) qf[8 + ks] = *(const bf16x8*)(Qr + qrow * 2048 + h * 64 + ks * 16 + hi * 8);
        f32x16 o[4];
#pragma unroll
        for (int d = 0; d < 4; ++d)
#pragma unroll
            for (int r = 0; r < 16; ++r) o[d][r] = 0.f;
        float mrun = -INFINITY, lsum = 0.f;
        const int ntiles = qb * 4 + 4;
        const int kn_key0 = tid >> 4, kn_ch = tid & 15;
        const int kr_key = tid >> 3, kr_ch = tid & 7;
        const int v_d0 = tid >> 3, v_ch = tid & 7;
        const bf16_t* gkn = Kn + ((size_t)bh * S_ + kn_key0) * 128 + kn_ch * 8;
        const bf16_t* gkr = Kr + ((size_t)b * S_ + kr_key) * 64 + kr_ch * 8;
        const bf16_t* gv = Vt + ((size_t)bh * 128 + v_d0) * S_ + v_ch * 8;
        u32x4 pk0, pk1, pkr, pv0, pv1;
        pk0 = *(const u32x4*)(gkn); pk1 = *(const u32x4*)(gkn + 32 * 128); pkr = *(const u32x4*)(gkr); pv0 = *(const u32x4*)(gv); pv1 = *(const u32x4*)(gv + (size_t)64 * S_);
        __syncthreads();
        *(LAS u32x4*)(sK + kn_key0 * 400 + kn_ch * 16) = pk0; *(LAS u32x4*)(sK + (kn_key0 + 32) * 400 + kn_ch * 16) = pk1; *(LAS u32x4*)(sK + kr_key * 400 + 256 + kr_ch * 16) = pkr;
        *(LAS u32x4*)(sV + v_d0 * 144 + v_ch * 16) = pv0; *(LAS u32x4*)(sV + (v_d0 + 64) * 144 + v_ch * 16) = pv1;
        __syncthreads();
        for (int kt = 0; kt < ntiles; ++kt) {
            const bool more = (kt + 1 < ntiles);
            const int cur = (kt & 1) * ABUF, nxt = ABUF - cur;
            if (more) { const size_t ko = (size_t)(kt + 1) * 64;
                pk0 = *(const u32x4*)(gkn + ko * 128); pk1 = *(const u32x4*)(gkn + (ko + 32) * 128); pkr = *(const u32x4*)(gkr + ko * 64); pv0 = *(const u32x4*)(gv + ko); pv1 = *(const u32x4*)(gv + (size_t)64 * S_ + ko); }
            const int kmin = kt * 64;
            if (kmin <= q0 + 31) {
                const LAS unsigned char* cK = sK + cur; const LAS unsigned char* cV = sV + cur;
                f32x16 s0, s1;
#pragma unroll
                for (int r = 0; r < 16; ++r) { s0[r] = 0.f; s1[r] = 0.f; }
                {
                    bf16x8 A0[4], A1[4], B0[4], B1[4];
#define LDK(D0, D1, K4) _Pragma("unroll") for (int kk2 = 0; kk2 < 4; ++kk2) { D0[kk2] = *(const LAS bf16x8*)(cK + l32 * 400 + ((K4) + kk2) * 32 + hi * 16); D1[kk2] = *(const LAS bf16x8*)(cK + (32 + l32) * 400 + ((K4) + kk2) * 32 + hi * 16); }
#define MMK(D0, D1, K4) _Pragma("unroll") for (int kk2 = 0; kk2 < 4; ++kk2) { s0 = __builtin_amdgcn_mfma_f32_32x32x16_bf16(D0[kk2], qf[(K4) + kk2], s0, 0, 0, 0); s1 = __builtin_amdgcn_mfma_f32_32x32x16_bf16(D1[kk2], qf[(K4) + kk2], s1, 0, 0, 0); }
                    LDK(A0, A1, 0) LDK(B0, B1, 4)
                    MMK(A0, A1, 0)
                    LDK(A0, A1, 8)
                    MMK(B0, B1, 4)
                    MMK(A0, A1, 8)
                    __builtin_amdgcn_sched_group_barrier(0x100, 6, 0);
#pragma unroll
                    for (int gI = 0; gI < 9; ++gI) { __builtin_amdgcn_sched_group_barrier(0x008, 2, 0); __builtin_amdgcn_sched_group_barrier(0x100, 2, 0); }
                    __builtin_amdgcn_sched_group_barrier(0x008, 6, 0);
#undef LDK
#undef MMK
                }
                if (kmin + 63 > q0) {
#pragma unroll
                    for (int r = 0; r < 16; ++r) { const int key = kmin + 8 * (r >> 2) + 4 * hi + (r & 3); if (key > qi) s0[r] = -INFINITY; if (key + 32 > qi) s1[r] = -INFINITY; }
                }
                float mx = s0[0];
#pragma unroll
                for (int r = 1; r < 16; ++r) mx = fmaxf(mx, s0[r]);
#pragma unroll
                for (int r = 0; r < 16; ++r) mx = fmaxf(mx, s1[r]);
                mx = fmaxf(mx, __shfl_xor(mx, 32));
                if (__builtin_amdgcn_ballot_w64(mx > mrun + 8.0f) != 0ull) {
                    const float mnew = fmaxf(mrun, mx); const float alpha = __builtin_amdgcn_exp2f(mrun - mnew); mrun = mnew;
                    lsum *= alpha;
#pragma unroll
                    for (int d = 0; d < 4; ++d)
#pragma unroll
                        for (int r = 0; r < 16; ++r) o[d][r] *= alpha;
                }
                float ps = 0.f;
#pragma unroll
                for (int r = 0; r < 16; ++r) { s0[r] = __builtin_amdgcn_exp2f(s0[r] - mrun); s1[r] = __builtin_amdgcn_exp2f(s1[r] - mrun); ps += s0[r] + s1[r]; }
                lsum += ps;
                bf16x8 pa[2][2];
#pragma unroll
                for (int t = 0; t < 2; ++t) {
                    u32x4 w0, w1;
                    w0.x = cvt_pk_bf16(s0[8 * t + 0], s0[8 * t + 1]); w0.y = cvt_pk_bf16(s0[8 * t + 2], s0[8 * t + 3]); w0.z = cvt_pk_bf16(s0[8 * t + 4], s0[8 * t + 5]); w0.w = cvt_pk_bf16(s0[8 * t + 6], s0[8 * t + 7]);
                    w1.x = cvt_pk_bf16(s1[8 * t + 0], s1[8 * t + 1]); w1.y = cvt_pk_bf16(s1[8 * t + 2], s1[8 * t + 3]); w1.z = cvt_pk_bf16(s1[8 * t + 4], s1[8 * t + 5]); w1.w = cvt_pk_bf16(s1[8 * t + 6], s1[8 * t + 7]);
                    pa[0][t] = __builtin_bit_cast(bf16x8, w0); pa[1][t] = __builtin_bit_cast(bf16x8, w1);
                }
                {
                    u32x4 Va[4], Vb[4];
#define LDV(D, G) _Pragma("unroll") for (int d = 0; d < 4; ++d) { D[d] = *(const LAS u32x4*)(cV + (d * 32 + l32) * 144 + (((G) >> 1) * 32 + ((G) & 1) * 16 + hi * 8) * 2); }
#define MMV(D, G) _Pragma("unroll") for (int d = 0; d < 4; ++d) o[d] = __builtin_amdgcn_mfma_f32_32x32x16_bf16(__builtin_bit_cast(bf16x8, D[d]), pa[(G) >> 1][(G) & 1], o[d], 0, 0, 0);
                    LDV(Va, 0) LDV(Vb, 1)
                    MMV(Va, 0)
                    LDV(Va, 2)
                    MMV(Vb, 1)
                    LDV(Vb, 3)
                    MMV(Va, 2)
                    MMV(Vb, 3)
#undef LDV
#undef MMV
                }
            }
            if (more) {
                *(LAS u32x4*)(sK + nxt + kn_key0 * 400 + kn_ch * 16) = pk0; *(LAS u32x4*)(sK + nxt + (kn_key0 + 32) * 400 + kn_ch * 16) = pk1; *(LAS u32x4*)(sK + nxt + kr_key * 400 + 256 + kr_ch * 16) = pkr;
                *(LAS u32x4*)(sV + nxt + v_d0 * 144 + v_ch * 16) = pv0; *(LAS u32x4*)(sV + nxt + (v_d0 + 64) * 144 + v_ch * 16) = pv1;
            }
            __syncthreads();
        }
        lsum += __shfl_xor(lsum, 32);
        const float inv = 1.0f / lsum;
        bf16_t* op = Qn + qrow * 2048 + h * 128;
        if (dummy) op = (bf16_t*)(ws + WS_NEED) + ((qrow * 2048 + h * 128) & (size_t)(4 * 1024 * 1024 - 1));
#pragma unroll
        for (int d = 0; d < 4; ++d)
#pragma unroll
            for (int r4 = 0; r4 < 4; ++r4) {
                u32x2 w; w.x = cvt_pk_bf16(o[d][4 * r4] * inv, o[d][4 * r4 + 1] * inv); w.y = cvt_pk_bf16(o[d][4 * r4 + 2] * inv, o[d][4 * r4 + 3] * inv);
                *(u32x2*)(op + d * 32 + 8 * r4 + 4 * hi) = w;
            }
    }
}

__device__ void final_phase(const KP& P) {
    float* X = P.out; const float* g = P.in[20]; const bf16_t* xhi = (const bf16_t*)(P.ws + OFF_XB2); const bf16_t* xlo = (const bf16_t*)P.out;
    const int tid = tid_opaque(); const int wid = tid >> 6, lane = tid & 63;
    for (int row = blockIdx.x * 8 + wid; row < T_; row += gridDim.x * 8) {
        f32x4 v[4]; float ss = 0.f;
#pragma unroll
        for (int i = 0; i < 4; ++i) { const u32x2 h = *(const u32x2*)(xhi + (size_t)row * D_ + i * 256 + lane * 4), l = *(const u32x2*)(xlo + (size_t)row * 2048 + i * 256 + lane * 4);
            v[i] = (f32x4){bflo(h.x) + bflo(l.x), bfhi(h.x) + bfhi(l.x), bflo(h.y) + bflo(l.y), bfhi(h.y) + bfhi(l.y)}; ss += (v[i][0] * v[i][0] + v[i][1] * v[i][1]) + (v[i][2] * v[i][2] + v[i][3] * v[i][3]); }
#pragma unroll
        for (int o = 32; o > 0; o >>= 1) ss += __shfl_xor(ss, o);
        const float rs = rsqrtf(ss * (1.0f / 1024.0f) + EPS_);
#pragma unroll
        for (int i = 0; i < 4; ++i) { const f32x4 gg = *(const f32x4*)(g + i * 256 + lane * 4); *(f32x4*)(X + (size_t)row * D_ + i * 256 + lane * 4) = v[i] * rs * gg; }
    }
}

constexpr size_t OFF_BAR = OFF_LB + 65536;
__device__ __forceinline__ unsigned xcc_id() { return (unsigned)__builtin_amdgcn_s_getreg((3 << 11) | 20) & 0xFu; }
__device__ __forceinline__ void gbar(unsigned* bar, unsigned k, unsigned x, unsigned gsize, unsigned nx) {
    asm volatile("s_waitcnt vmcnt(0)" ::: "memory");
    __syncthreads();
    if (threadIdx.x == 0) {
        const unsigned old = __hip_atomic_fetch_add(bar + 64 * (16 + x), 1u, __ATOMIC_RELAXED, __HIP_MEMORY_SCOPE_AGENT);
        if (old + 1u == k * gsize) {
            __builtin_amdgcn_fence(__ATOMIC_RELEASE, "agent");
            asm volatile("s_waitcnt vmcnt(0)" ::: "memory");
            const unsigned old2 = __hip_atomic_fetch_add(bar + 64 * 32, 1u, __ATOMIC_RELAXED, __HIP_MEMORY_SCOPE_AGENT);
            if (old2 + 1u == k * nx) { for (unsigned j = 0; j < 16; ++j) __hip_atomic_store(bar + 64 * (33 + j), k, __ATOMIC_RELAXED, __HIP_MEMORY_SCOPE_AGENT); }
        }
        unsigned spins = 0;
        while (__hip_atomic_load(bar + 64 * (33 + x), __ATOMIC_RELAXED, __HIP_MEMORY_SCOPE_AGENT) < k && ++spins < (1u << 24)) __builtin_amdgcn_s_sleep(1);
        __builtin_amdgcn_fence(__ATOMIC_ACQUIRE, "agent");
        asm volatile("s_waitcnt vmcnt(0)" ::: "memory");
    }
    __syncthreads();
}
enum { PH_PREP = 0, PH_GEMM = 1, PH_HA = 2, PH_HB = 3, PH_HC = 4, PH_ATTN = 5, PH_FINAL = 6 };
constexpr int N_PHASES = 21;

__device__ __forceinline__ GemmJob mk(const void* A, const void* Bt, int N, int K, int epi, int rot) {
    GemmJob j; j.A = (const bf16_t*)A; j.Bt = (const bf16_t*)Bt; j.M = T_; j.N = N; j.K = K; j.epi = epi; j.rot = rot; j.ssq = nullptr; j.np = 16; j.invdim = 1.0f / 1024.0f;
    j.o0 = j.o1 = j.o2 = j.o3 = nullptr; j.i0 = j.i1 = nullptr; j.f0 = 1.0f; return j;
}
__device__ __forceinline__ int get_phase(const KP& P, int ph, GemmJob& j0, GemmJob& j1, int& nj) {
    unsigned char* ws = P.ws; nj = 1;
    const float* ssq0 = (const float*)(ws + OFF_SSQ0); const float* ssq1 = (const float*)(ws + OFF_SSQ1);
    auto ffn1 = [&](int l, int jj, const float* ssq) { GemmJob j = mk(ws + OFF_XB, ws + OFF_FI + (size_t)(l * 2 + jj) * SZ_FI, 2 * FF_, D_, EPI_SWIGLU, 0); j.ssq = ssq; j.o0 = ws + OFF_ACT; return j; };
    auto resid = [&](const void* A, const void* Bt, int K, float sc, size_t srchi, size_t ssqo) { GemmJob j = mk(A, Bt, D_, K, EPI_RESID, 0); j.o0 = P.out; j.o1 = ws + OFF_XB; j.o2 = ws + ssqo; j.i0 = ws + srchi; j.f0 = sc; return j; };
    auto pej = [&](int l) { GemmJob j = mk(ws + OFF_PB + (size_t)l * T_ * 256 * 2, ws + OFF_PI + (size_t)l * (MiB / 2), D_, 256, EPI_BF16, 0); j.o0 = ws + OFF_PE; return j; };
    auto plej = [&](int l) { GemmJob j = mk(ws + OFF_XB, ws + OFF_PG + (size_t)l * 2 * MiB, D_, D_, EPI_PLE, 0); j.ssq = ssq1; j.o0 = P.out; j.o1 = ws + OFF_XB2; j.o2 = ws + OFF_SSQ0; j.i0 = ws + OFF_XB; j.i1 = ws + OFF_PE; return j; };
    switch (ph) {
    case 0: return PH_PREP;
    case 1: j0 = ffn1(0, 0, ssq0); return PH_GEMM;
    case 2: j0 = resid(ws + OFF_ACT, ws + OFF_FO + 0 * SZ_FO, FF_, 0.5f, OFF_XB, OFF_SSQ1); return PH_GEMM;
    case 3: { j0 = mk(ws + OFF_XB, ws + OFF_AIN, 4096, D_, EPI_HGRN, 0); j0.ssq = ssq1; j0.o0 = ws + OFF_HQ; j0.o1 = ws + OFF_HKK; j0.o2 = ws + OFF_HV; j0.o3 = ws + OFF_HOG; j0.i0 = ws + OFF_LB; return PH_GEMM; }
    case 4: return PH_HA;
    case 5: return PH_HB;
    case 6: return PH_HC;
    case 7: j0 = resid(ws + OFF_HQ, ws + OFF_AOUT, D_, 1.0f, OFF_XB, OFF_SSQ0); return PH_GEMM;
    case 8: j0 = ffn1(0, 1, ssq0); j1 = pej(0); j1.rot = 128; nj = 2; return PH_GEMM;
    case 9: j0 = resid(ws + OFF_ACT, ws + OFF_FO + 1 * SZ_FO, FF_, 0.5f, OFF_XB, OFF_SSQ1); return PH_GEMM;
    case 10: j0 = plej(0); return PH_GEMM;
    case 11: { j0 = ffn1(1, 0, ssq0); j0.A = (const bf16_t*)(ws + OFF_XB2); j1 = mk(ws + OFF_XB2, ws + OFF_KVD, 512, D_, EPI_KVDOWN, 128); j1.ssq = ssq0; j1.o0 = ws + OFF_CKV; j1.o1 = ws + OFF_SSQCKV; j1.o2 = ws + OFF_KROPE; j1.i0 = ws + OFF_ROPE; nj = 2; return PH_GEMM; }
    case 12: j0 = resid(ws + OFF_ACT, ws + OFF_FO + 2 * SZ_FO, FF_, 0.5f, OFF_XB2, OFF_SSQ1); return PH_GEMM;
    case 13: { j0 = mk(ws + OFF_XB, ws + OFF_DQ, 512, D_, EPI_CQ, 0); j0.ssq = ssq1; j0.o0 = ws + OFF_CQ; j0.o1 = ws + OFF_SSQCQ;
               j1 = mk(ws + OFF_CKV, ws + OFF_KVU, 4096, 256, EPI_KVUP, 128); j1.ssq = (const float*)(ws + OFF_SSQCKV); j1.np = 4; j1.invdim = 1.0f / 256.0f; j1.o0 = ws + OFF_KNOPE; j1.o1 = ws + OFF_VT; nj = 2; return PH_GEMM; }
    case 14: { j0 = mk(ws + OFF_CQ, ws + OFF_UQ, 3072, 512, EPI_QUP, 0); j0.ssq = (const float*)(ws + OFF_SSQCQ); j0.np = 8; j0.invdim = 1.0f / 512.0f; j0.o0 = ws + OFF_QNOPE; j0.o1 = (bf16_t*)P.out + 1024; j0.i0 = ws + OFF_ROPE;
               j0.f0 = 0.07216878364870322f * 1.4426950408889634f; return PH_GEMM; }
    case 15: return PH_ATTN;
    case 16: j0 = resid(ws + OFF_QNOPE, ws + OFF_BO, 2048, 1.0f, OFF_XB, OFF_SSQ0); return PH_GEMM;
    case 17: j0 = ffn1(1, 1, ssq0); j1 = pej(1); j1.rot = 128; nj = 2; return PH_GEMM;
    case 18: j0 = resid(ws + OFF_ACT, ws + OFF_FO + 3 * SZ_FO, FF_, 0.5f, OFF_XB, OFF_SSQ1); return PH_GEMM;
    case 19: j0 = plej(1); return PH_GEMM;
    default: return PH_FINAL;
    }
}

constexpr int TAB_OFF = 132096, TAB_SLOT = 320;
static_assert(sizeof(GemmJob) <= 152 && TAB_OFF + N_PHASES * TAB_SLOT <= LDS_BYTES, "phase table");
__global__ void __launch_bounds__(512, 2) yoco_fwd(KP P, int ph_lo, int ph_hi) {
    extern __shared__ __attribute__((aligned(16))) unsigned char smem_raw[];
    LAS unsigned char* lds = (LAS unsigned char*)smem_raw;
    cg::grid_group grid = cg::this_grid();
    if (threadIdx.x < N_PHASES) {
        GemmJob j0 = mk(nullptr, nullptr, 256, 256, 0, 0), j1 = j0; int nj = 1;
        const int kind = get_phase(P, threadIdx.x, j0, j1, nj);
        LAS unsigned char* slot = lds + TAB_OFF + threadIdx.x * TAB_SLOT;
        *(LAS int*)slot = kind; *(LAS int*)(slot + 4) = nj;
        { const unsigned* s0 = (const unsigned*)&j0; const unsigned* s1 = (const unsigned*)&j1;
#pragma unroll
          for (int w = 0; w < (int)(sizeof(GemmJob) / 4); ++w) { *(LAS unsigned*)(slot + 16 + 4 * w) = s0[w]; *(LAS unsigned*)(slot + 16 + 152 + 4 * w) = s1[w]; } }
    }
    __syncthreads();
    if (threadIdx.x == 0) __hip_atomic_fetch_add((unsigned*)(P.ws + OFF_BAR) + 64 * xcc_id(), 1u, __ATOMIC_RELAXED, __HIP_MEMORY_SCOPE_AGENT);
    for (int ph = ph_lo; ph < ph_hi; ++ph) {
        const LAS unsigned char* slot = lds + TAB_OFF + ph * TAB_SLOT;
        const int kind = __builtin_amdgcn_readfirstlane(*(const LAS int*)slot), nj = __builtin_amdgcn_readfirstlane(*(const LAS int*)(slot + 4));
        if (kind == PH_GEMM) {
            for (int ji = 0; ji < nj; ++ji) {
                const LAS GemmJob* J = (const LAS GemmJob*)(slot + 16 + ji * 152);
                Sched S; S.init(__builtin_amdgcn_readfirstlane(J->M), __builtin_amdgcn_readfirstlane(J->N), gridDim.x, blockIdx.x, __builtin_amdgcn_readfirstlane(J->rot));
                gemm_phase<true, true>(lds, J, S);
                __syncthreads();
            }
        } else if (kind == PH_PREP) prep_phase(P, lds);
        else if (kind == PH_HA) hgrn_a(P, lds);
        else if (kind == PH_HB) hgrn_b(P);
        else if (kind == PH_HC) hgrn_c(P, lds);
        else if (kind == PH_ATTN) {
            attn_phase(P, lds);
        }
        else final_phase(P);
        if (ph + 1 < ph_hi) {
            unsigned* bar = (unsigned*)(P.ws + OFF_BAR);
            if (ph == ph_lo) {
                grid.sync();
                if (threadIdx.x == 0) { const unsigned xcc = xcc_id(); unsigned n = 0, mine = 1;
                    for (int j = 0; j < 16; ++j) { const unsigned c = __hip_atomic_load(bar + 64 * j, __ATOMIC_RELAXED, __HIP_MEMORY_SCOPE_AGENT); n += (c > 0u); if ((unsigned)j == xcc) mine = c; }
                    *(LAS unsigned*)(lds + TAB_OFF - 16) = mine; *(LAS unsigned*)(lds + TAB_OFF - 12) = n; *(LAS unsigned*)(lds + TAB_OFF - 8) = xcc; }
                __syncthreads();
            } else gbar(bar, (unsigned)(ph - ph_lo), *(LAS unsigned*)(lds + TAB_OFF - 8), *(LAS unsigned*)(lds + TAB_OFF - 16), *(LAS unsigned*)(lds + TAB_OFF - 12));
        }
    }
}

extern "C" void kernel_launch(void* const* d_in, const int* in_sizes, int n_in, void* d_out, int out_size, void* d_ws, size_t ws_size, hipStream_t stream) {
    static int grid_blocks = 0;
    if (grid_blocks == 0) {
        if (n_in != 21 || ws_size < WS_NEED) { fprintf(stderr, "kernel_launch: unexpected inputs (%d) or workspace %zu < %zu\n", n_in, ws_size, (size_t)WS_NEED); grid_blocks = -1; return; }
        int dev = 0, cus = 0, per_cu = 0;
        (void)hipGetDevice(&dev); (void)hipDeviceGetAttribute(&cus, hipDeviceAttributeMultiprocessorCount, dev);
        if (hipFuncSetAttribute((const void*)yoco_fwd, hipFuncAttributeMaxDynamicSharedMemorySize, LDS_BYTES) != hipSuccess) { fprintf(stderr, "kernel_launch: hipFuncSetAttribute failed\n"); grid_blocks = -1; return; }
        if (hipOccupancyMaxActiveBlocksPerMultiprocessor(&per_cu, (const void*)yoco_fwd, 512, LDS_BYTES) != hipSuccess || per_cu < 1) { fprintf(stderr, "kernel_launch: occupancy query says %d\n", per_cu); per_cu = 1; }
        (void)hipGetLastError();
        grid_blocks = cus * 1;
        fprintf(stderr, "kernel_launch: cus %d per_cu %d grid %d\n", cus, per_cu, grid_blocks);
    }
    if (grid_blocks < 0) return;
    KP p{};
    for (int i = 0; i < 21; ++i) p.in[i] = (const float*)d_in[i];
    p.out = (float*)d_out; p.ws = (unsigned char*)d_ws;
    for (int f = 0; f < 32; ++f) { const float ex = (float)f / 32.0f; const float pw = (float)std::pow(10000.0, (double)ex); p.inv_freq[f] = 1.0f / pw; }
    (void)hipMemsetAsync((unsigned char*)d_ws + OFF_BAR, 0, 16384, stream);
    int lo = 0, hi = N_PHASES;
    void* args[] = {&p, &lo, &hi};
    hipError_t e = hipLaunchCooperativeKernel((const void*)yoco_fwd, dim3(grid_blocks), dim3(512), args, LDS_BYTES, stream);
    if (e != hipSuccess) fprintf(stderr, "cooperative launch failed: %s (grid %d)\n", hipGetErrorString(e), grid_blocks);
}
```

```cpp
#include <hip/hip_runtime.h>
#include <hip/hip_cooperative_groups.h>
#include <cstdio>
#include <cstdint>
#include <cmath>
namespace cg = cooperative_groups;

#define LAS __attribute__((address_space(3)))
typedef unsigned short bf16_t;
typedef short bf16x8 __attribute__((ext_vector_type(8)));
typedef short s16x4 __attribute__((ext_vector_type(4)));
typedef float f32x4 __attribute__((ext_vector_type(4)));
typedef float f32x2 __attribute__((ext_vector_type(2)));
typedef float f32x16 __attribute__((ext_vector_type(16)));
typedef unsigned u32x4 __attribute__((ext_vector_type(4)));
typedef unsigned u32x2 __attribute__((ext_vector_type(2)));

constexpr int T_ = 16384, S_ = 8192, D_ = 1024, FF_ = 2816;
constexpr float EPS_ = 1e-6f;
constexpr int LDS_BYTES = 147456;

constexpr size_t MiB = 1u << 20;
constexpr size_t SZ_FI = 5632ull * 1024 * 2, SZ_FO = 1024ull * 2816 * 2;
constexpr size_t OFF_FI = 0;
constexpr size_t OFF_FO = OFF_FI + 4 * SZ_FI;
constexpr size_t OFF_PG = OFF_FO + 4 * SZ_FO;
constexpr size_t OFF_PI = OFF_PG + 4 * MiB;
constexpr size_t OFF_AIN = OFF_PI + 1 * MiB;
constexpr size_t OFF_AOUT = OFF_AIN + 8 * MiB;
constexpr size_t OFF_KVD = OFF_AOUT + 2 * MiB;
constexpr size_t OFF_KVU = OFF_KVD + 1 * MiB;
constexpr size_t OFF_DQ = OFF_KVU + 2 * MiB;
constexpr size_t OFF_UQ = OFF_DQ + 1 * MiB;
constexpr size_t OFF_BO = OFF_UQ + 3 * MiB;
constexpr size_t OFF_SSQ0 = OFF_BO + 4 * MiB;
constexpr size_t OFF_SSQ1 = OFF_SSQ0 + 1 * MiB;
constexpr size_t OFF_SSQCKV = OFF_SSQ1 + 1 * MiB;
constexpr size_t OFF_SSQCQ = OFF_SSQCKV + MiB / 2;
constexpr size_t OFF_DEC = OFF_SSQCQ + MiB / 2;
constexpr size_t OFF_LB = OFF_DEC + 1 * MiB;
constexpr size_t OFF_ROPE = OFF_LB + 1 * MiB;
constexpr size_t OFF_PB = OFF_ROPE + 4 * MiB;
constexpr size_t OFF_XB = OFF_PB + 16 * MiB;
constexpr size_t OFF_POOL = OFF_XB + 32 * MiB;
constexpr size_t OFF_ACT = OFF_POOL;
constexpr size_t OFF_HQ = OFF_POOL;
constexpr size_t OFF_HV = OFF_POOL + 32 * MiB;
constexpr size_t OFF_HOG = OFF_POOL + 64 * MiB;
constexpr size_t OFF_HKK = OFF_POOL + 96 * MiB;
constexpr size_t OFF_HKN = OFF_POOL + 160 * MiB;
constexpr size_t OFF_PE = OFF_POOL + 96 * MiB;
constexpr size_t OFF_KNOPE = OFF_POOL;
constexpr size_t OFF_VT = OFF_POOL + 64 * MiB;
constexpr size_t OFF_QNOPE = OFF_POOL + 128 * MiB;
constexpr size_t OFF_CKV = OFF_POOL + 128 * MiB;
constexpr size_t OFF_XB2 = OFF_POOL + 160 * MiB;
constexpr size_t OFF_CQ = OFF_FI;
constexpr size_t OFF_KROPE = OFF_FI + 16 * MiB;
constexpr size_t WS_NEED = OFF_POOL + 192 * MiB;

struct KP { const float* in[21]; float* out; unsigned char* ws; float inv_freq[32]; };

__device__ __forceinline__ int tid_opaque() { int t = threadIdx.x; asm volatile("" : "+v"(t)); return t; }
typedef __bf16 bf16x2_t __attribute__((ext_vector_type(2)));
__device__ __forceinline__ unsigned cvt_pk_bf16(float lo, float hi) { const f32x2 v = {lo, hi}; const bf16x2_t b = __builtin_convertvector(v, bf16x2_t); return __builtin_bit_cast(unsigned, b); }
__device__ __forceinline__ float bf2f(unsigned short b) { return __uint_as_float(((unsigned)b) << 16); }
__device__ __forceinline__ float bflo(unsigned w) { return __uint_as_float(w << 16); }
__device__ __forceinline__ float bfhi(unsigned w) { return __uint_as_float(w & 0xffff0000u); }
__device__ __forceinline__ float frcp(float x) { return __builtin_amdgcn_rcpf(x); }
__device__ __forceinline__ float sigmoidf_(float x) { return frcp(1.0f + __expf(-x)); }
__device__ __forceinline__ u32x4 pack8(f32x4 a, f32x4 b) { u32x4 w; w.x = cvt_pk_bf16(a[0], a[1]); w.y = cvt_pk_bf16(a[2], a[3]); w.z = cvt_pk_bf16(b[0], b[1]); w.w = cvt_pk_bf16(b[2], b[3]); return w; }

constexpr int BM = 256, BK = 64, HALF = 128, HTB = HALF * BK * 2, STAGE_BYTES = 8 * HTB, NXCD = 8, WGM = 4;
__host__ __device__ __forceinline__ int lds_byte(int r, int c) { const int st = (r >> 4) * 2 + (c >> 5), rr = r & 15, cc = c & 31, ob = rr * 64 + cc * 2; return st * 1024 + (ob ^ (((ob >> 9) & 1) << 5)); }
__host__ __device__ __forceinline__ void stage_rc(int b, int& R, int& C) { const int st = b / 1024, sb = b % 1024, swz = sb ^ (((sb >> 9) & 1) << 5); R = (st >> 1) * 16 + swz / 64; C = (st & 1) * 32 + (swz % 64) / 2; }
__host__ __device__ __forceinline__ int perm32(int rho) { const int n = rho >> 4, i = rho & 15; return 8 * (i >> 2) + 4 * n + (i & 3); }

struct Unit { int pm, pn; };
enum { EPI_SWIGLU = 0, EPI_RESID = 1, EPI_PLE = 2, EPI_HGRN = 3, EPI_BF16 = 4, EPI_KVDOWN = 5, EPI_CQ = 6, EPI_KVUP = 7, EPI_QUP = 8 };
struct GemmJob {
    const bf16_t* A; const bf16_t* Bt; int M, N, K; int epi; int rot;
    const float* ssq; int np; float invdim;
    void* o0; void* o1; void* o2; void* o3; const void* i0; const void* i1; float f0;
};
struct Sched {
    int nM, nN, nwg, G, c;
    __device__ void init(int M, int N, int G_, int c_, int rot) { nM = M / BM; nN = N / BM; nwg = nM * nN; G = G_; c = (c_ + G_ - (rot % G_)) % G_; }
    __device__ bool next(int i, Unit& u) const {
        const long L = (long)i * G + c; if (L >= nwg) return false;
        int wgid = (int)L; { const int q = nwg / NXCD, r = nwg % NXCD, xcd = wgid % NXCD, off = wgid / NXCD; wgid = (xcd < r ? xcd * (q + 1) : r * (q + 1) + (xcd - r) * q) + off; }
        const int nig = WGM * nN, gid = wgid / nig, fm = gid * WGM, gsz = (nM - fm) < WGM ? (nM - fm) : WGM;
        u.pm = fm + ((wgid % nig) % gsz); u.pn = (wgid % nig) / gsz; return true;
    }
};

__device__ __forceinline__ float row_rstd(const float* ssq, int np, int row, float invdim) {
    const f32x4* p = (const f32x4*)(ssq + (size_t)row * np); float s = 0.f;
    for (int i = 0; i < (np >> 2); ++i) { const f32x4 v = p[i]; s += (v[0] + v[1]) + (v[2] + v[3]); }
    return rsqrtf(s * invdim + EPS_);
}
__device__ __forceinline__ float sumsq8(f32x4 a, f32x4 b) { return (a[0] * a[0] + a[1] * a[1]) + (a[2] * a[2] + a[3] * a[3]) + (b[0] * b[0] + b[1] * b[1]) + (b[2] * b[2] + b[3] * b[3]); }

__device__ __forceinline__ void epilogue(const f32x4 (&acc)[2][2][4][2], const LAS GemmJob* Jp, int pm, int pn, int wr, int wc, int fr, int fq) {
    const int rbase = pm * BM + wr * 64 + fr;
    const int cl = wc * 32 + 8 * fq;
    const LAS GemmJob& J = *Jp;
    const int epi = __builtin_amdgcn_readfirstlane(J.epi);
    float rs8[2][4];
    if (epi != EPI_RESID && epi != EPI_BF16) {
        const float* ssq = J.ssq; const int np = J.np; const float invdim = J.invdim;
        f32x4 pv[2][4];
#pragma unroll
        for (int ai = 0; ai < 2; ++ai)
#pragma unroll
            for (int m = 0; m < 4; ++m) { const int row = rbase + ai * HALF + m * 16; pv[ai][m] = (4 * fq < np) ? *(const f32x4*)(ssq + (size_t)row * np + 4 * fq) : (f32x4){0.f, 0.f, 0.f, 0.f}; }
#pragma unroll
        for (int ai = 0; ai < 2; ++ai)
#pragma unroll
            for (int m = 0; m < 4; ++m) { float t = (pv[ai][m][0] + pv[ai][m][1]) + (pv[ai][m][2] + pv[ai][m][3]); t += __shfl_xor(t, 16); t += __shfl_xor(t, 32); rs8[ai][m] = rsqrtf(t * invdim + EPS_); }
    } else {
#pragma unroll
        for (int ai = 0; ai < 2; ++ai)
#pragma unroll
            for (int m = 0; m < 4; ++m) rs8[ai][m] = 0.f;
    }
    switch (epi) {
    case EPI_SWIGLU: {
        bf16_t* act = (bf16_t*)J.o0;
#pragma unroll
        for (int ai = 0; ai < 2; ++ai)
#pragma unroll
            for (int m = 0; m < 4; ++m) {
                const int row = rbase + ai * HALF + m * 16; const float rs = rs8[ai][m];
                f32x4 h[2];
#pragma unroll
                for (int n = 0; n < 2; ++n)
#pragma unroll
                    for (int j = 0; j < 4; ++j) { const float g = acc[ai][0][m][n][j] * rs, u = acc[ai][1][m][n][j] * rs; h[n][j] = g * frcp(1.0f + __expf(-g)) * u; }
                *(u32x4*)(act + (size_t)row * FF_ + pn * 128 + cl) = pack8(h[0], h[1]);
            }
    } break;
    case EPI_RESID: case EPI_PLE: {
        bf16_t* xlo = (bf16_t*)J.o0; bf16_t* xbd = (bf16_t*)J.o1; float* ssqo = (float*)J.o2; const bf16_t* xbs = (const bf16_t*)J.i0; const bf16_t* pe = (const bf16_t*)J.i1;
        const bool ple = (epi == EPI_PLE); const float sc = J.f0;
#pragma unroll
        for (int ai = 0; ai < 2; ++ai)
#pragma unroll
        for (int mh = 0; mh < 2; ++mh) {
            u32x4 XH[2][2], XL[2][2];
#pragma unroll
            for (int mm = 0; mm < 2; ++mm)
#pragma unroll
                for (int bj = 0; bj < 2; ++bj) { const int row = rbase + ai * HALF + (2 * mh + mm) * 16; const int col = pn * BM + bj * HALF + cl; XH[mm][bj] = *(const u32x4*)(xbs + (size_t)row * D_ + col); XL[mm][bj] = *(const u32x4*)(xlo + (size_t)row * 2048 + col); }
#pragma unroll
            for (int mm = 0; mm < 2; ++mm) {
                const int m = 2 * mh + mm;
                const int row = rbase + ai * HALF + m * 16; const float rs = rs8[ai][m];
                float ss = 0.f;
#pragma unroll
                for (int bj = 0; bj < 2; ++bj) {
                    const int col = pn * BM + bj * HALF + cl; const size_t off = (size_t)row * D_ + col;
                    const u32x4 h = XH[mm][bj], l = XL[mm][bj];
                    f32x4 x0 = (f32x4){bflo(h.x) + bflo(l.x), bfhi(h.x) + bfhi(l.x), bflo(h.y) + bflo(l.y), bfhi(h.y) + bfhi(l.y)};
                    f32x4 x1 = (f32x4){bflo(h.z) + bflo(l.z), bfhi(h.z) + bfhi(l.z), bflo(h.w) + bflo(l.w), bfhi(h.w) + bfhi(l.w)};
                    f32x4 d0 = acc[ai][bj][m][0], d1 = acc[ai][bj][m][1];
                    if (ple) {
                        const u32x4 pw = *(const u32x4*)(pe + off);
                        d0[0] = sigmoidf_(d0[0] * rs) * bflo(pw.x); d0[1] = sigmoidf_(d0[1] * rs) * bfhi(pw.x); d0[2] = sigmoidf_(d0[2] * rs) * bflo(pw.y); d0[3] = sigmoidf_(d0[3] * rs) * bfhi(pw.y);
                        d1[0] = sigmoidf_(d1[0] * rs) * bflo(pw.z); d1[1] = sigmoidf_(d1[1] * rs) * bfhi(pw.z); d1[2] = sigmoidf_(d1[2] * rs) * bflo(pw.w); d1[3] = sigmoidf_(d1[3] * rs) * bfhi(pw.w);
                    } else { d0 = d0 * sc; d1 = d1 * sc; }
                    x0 = x0 + d0; x1 = x1 + d1;
                    const u32x4 nh = pack8(x0, x1);
                    const f32x4 r0 = (f32x4){x0[0] - bflo(nh.x), x0[1] - bfhi(nh.x), x0[2] - bflo(nh.y), x0[3] - bfhi(nh.y)};
                    const f32x4 r1 = (f32x4){x1[0] - bflo(nh.z), x1[1] - bfhi(nh.z), x1[2] - bflo(nh.w), x1[3] - bfhi(nh.w)};
                    *(u32x4*)(xbd + off) = nh;
                    *(u32x4*)(xlo + (size_t)row * 2048 + col) = pack8(r0, r1);
                    ss += sumsq8(x0, x1);
                }
                ss += __shfl_xor(ss, 16); ss += __shfl_xor(ss, 32);
                if (fq == 0) ssqo[(size_t)row * 16 + pn * 4 + wc] = ss;
            }
        }
    } break;
    case EPI_HGRN: {
        const int sec = pn >> 2; const float* lb = (const float*)J.i0;
#pragma unroll
        for (int ai = 0; ai < 2; ++ai)
#pragma unroll
            for (int m = 0; m < 4; ++m) {
                const int row = rbase + ai * HALF + m * 16; const float rs = rs8[ai][m];
#pragma unroll
                for (int bj = 0; bj < 2; ++bj) {
                    const int cs = (pn & 3) * BM + bj * HALF + cl; const size_t off = (size_t)row * D_ + cs;
                    f32x4 v0 = acc[ai][bj][m][0] * rs, v1 = acc[ai][bj][m][1] * rs;
                    if (sec == 0) { v0 = v0 * 0.08838834764831845f; v1 = v1 * 0.08838834764831845f; *(u32x4*)((bf16_t*)J.o0 + off) = pack8(v0, v1); }
                    else if (sec == 1) {
                        const f32x4 l0 = *(const f32x4*)(lb + cs), l1 = *(const f32x4*)(lb + cs + 4);
#pragma unroll
                        for (int j = 0; j < 4; ++j) { v0[j] = (1.0f - l0[j]) * frcp(1.0f + __expf(v0[j])); v1[j] = (1.0f - l1[j]) * frcp(1.0f + __expf(v1[j])); }
                        *(f32x4*)((float*)J.o1 + off) = v0; *(f32x4*)((float*)J.o1 + off + 4) = v1;
                    } else if (sec == 2) { *(u32x4*)((bf16_t*)J.o2 + off) = pack8(v0, v1); }
                    else {
#pragma unroll
                        for (int j = 0; j < 4; ++j) { v0[j] = sigmoidf_(v0[j]); v1[j] = sigmoidf_(v1[j]); }
                        *(u32x4*)((bf16_t*)J.o3 + off) = pack8(v0, v1);
                    }
                }
            }
    } break;
    case EPI_BF16: {
        bf16_t* o = (bf16_t*)J.o0;
#pragma unroll
        for (int ai = 0; ai < 2; ++ai)
#pragma unroll
            for (int m = 0; m < 4; ++m) {
                const int row = rbase + ai * HALF + m * 16;
#pragma unroll
                for (int bj = 0; bj < 2; ++bj) *(u32x4*)(o + (size_t)row * J.N + pn * BM + bj * HALF + cl) = pack8(acc[ai][bj][m][0], acc[ai][bj][m][1]);
            }
    } break;
    case EPI_CQ: {
        bf16_t* o = (bf16_t*)J.o0; float* so = (float*)J.o1;
#pragma unroll
        for (int ai = 0; ai < 2; ++ai)
#pragma unroll
            for (int m = 0; m < 4; ++m) {
                const int row = rbase + ai * HALF + m * 16; const float rs = rs8[ai][m]; float ss = 0.f;
#pragma unroll
                for (int bj = 0; bj < 2; ++bj) { const f32x4 v0 = acc[ai][bj][m][0] * rs, v1 = acc[ai][bj][m][1] * rs; *(u32x4*)(o + (size_t)row * 512 + pn * BM + bj * HALF + cl) = pack8(v0, v1); ss += sumsq8(v0, v1); }
                ss += __shfl_xor(ss, 16); ss += __shfl_xor(ss, 32);
                if (fq == 0) so[(size_t)row * 8 + pn * 4 + wc] = ss;
            }
    } break;
    case EPI_KVDOWN: {
        bf16_t* ckv = (bf16_t*)J.o0; float* so = (float*)J.o1; bf16_t* kr = (bf16_t*)J.o2; const f32x2* rope = (const f32x2*)J.i0;
        if (pn == 0) {
#pragma unroll
            for (int ai = 0; ai < 2; ++ai)
#pragma unroll
                for (int m = 0; m < 4; ++m) {
                    const int row = rbase + ai * HALF + m * 16; const float rs = rs8[ai][m]; float ss = 0.f;
#pragma unroll
                    for (int bj = 0; bj < 2; ++bj) { const f32x4 v0 = acc[ai][bj][m][0] * rs, v1 = acc[ai][bj][m][1] * rs; *(u32x4*)(ckv + (size_t)row * 256 + bj * HALF + cl) = pack8(v0, v1); ss += sumsq8(v0, v1); }
                    ss += __shfl_xor(ss, 16); ss += __shfl_xor(ss, 32);
                    if (fq == 0) so[(size_t)row * 4 + wc] = ss;
                }
        } else if (wc == 0) {
#pragma unroll
            for (int ai = 0; ai < 2; ++ai)
#pragma unroll
                for (int m = 0; m < 4; ++m) {
                    const int row = rbase + ai * HALF + m * 16; const float rs = rs8[ai][m];
                    f32x4 a[2], b[2];
#pragma unroll
                    for (int n = 0; n < 2; ++n)
#pragma unroll
                        for (int j = 0; j < 4; ++j) { const f32x2 cs = rope[(size_t)row * 32 + 8 * fq + 4 * n + j]; const float x1 = acc[ai][0][m][n][j] * rs, x2 = acc[ai][1][m][n][j] * rs; a[n][j] = x1 * cs.x - x2 * cs.y; b[n][j] = x2 * cs.x + x1 * cs.y; }
                    *(u32x4*)(kr + (size_t)row * 64 + 8 * fq) = pack8(a[0], a[1]); *(u32x4*)(kr + (size_t)row * 64 + 32 + 8 * fq) = pack8(b[0], b[1]);
                }
        }
    } break;
    case EPI_KVUP: {
        bf16_t* kn = (bf16_t*)J.o0; bf16_t* vt = (bf16_t*)J.o1;
#pragma unroll
        for (int ai = 0; ai < 2; ++ai)
#pragma unroll
            for (int m = 0; m < 4; ++m) {
                const int row = rbase + ai * HALF + m * 16; const float rs = rs8[ai][m];
                const int b = row >> 13, s = row & (S_ - 1); const size_t bh = (size_t)b * 16 + pn;
                *(u32x4*)(kn + (bh * S_ + s) * 128 + cl) = pack8(acc[ai][0][m][0] * rs, acc[ai][0][m][1] * rs);
                const u32x4 w = pack8(acc[ai][1][m][0] * rs, acc[ai][1][m][1] * rs);
                const int sp = (s & ~15) | (((s >> 2) & 1) << 3) | (((s >> 3) & 1) << 2) | (s & 3);
                bf16_t* vp = vt + (bh * 128 + cl) * S_ + sp;
                vp[0 * S_] = (bf16_t)(w.x & 0xffff); vp[1 * S_] = (bf16_t)(w.x >> 16); vp[2 * S_] = (bf16_t)(w.y & 0xffff); vp[3 * S_] = (bf16_t)(w.y >> 16);
                vp[4 * S_] = (bf16_t)(w.z & 0xffff); vp[5 * S_] = (bf16_t)(w.z >> 16); vp[6 * S_] = (bf16_t)(w.w & 0xffff); vp[7 * S_] = (bf16_t)(w.w >> 16);
            }
    } break;
    case EPI_QUP: {
        bf16_t* qn = (bf16_t*)J.o0; bf16_t* qr = (bf16_t*)J.o1; const f32x2* rope = (const f32x2*)J.i0;
#pragma unroll
        for (int ai = 0; ai < 2; ++ai)
#pragma unroll
            for (int m = 0; m < 4; ++m) {
                const int row = rbase + ai * HALF + m * 16; const float rs = rs8[ai][m] * J.f0;
                if (pn < 8) {
#pragma unroll
                    for (int bj = 0; bj < 2; ++bj) *(u32x4*)(qn + (size_t)row * 2048 + pn * BM + bj * HALF + cl) = pack8(acc[ai][bj][m][0] * rs, acc[ai][bj][m][1] * rs);
                } else {
                    const int head = 4 * (pn - 8) + wc; f32x4 a[2], b[2];
#pragma unroll
                    for (int n = 0; n < 2; ++n)
#pragma unroll
                        for (int j = 0; j < 4; ++j) { const f32x2 cs = rope[(size_t)row * 32 + 8 * fq + 4 * n + j]; const float x1 = acc[ai][0][m][n][j] * rs, x2 = acc[ai][1][m][n][j] * rs; a[n][j] = x1 * cs.x - x2 * cs.y; b[n][j] = x2 * cs.x + x1 * cs.y; }
                    *(u32x4*)(qr + (size_t)row * 2048 + head * 64 + 8 * fq) = pack8(a[0], a[1]); *(u32x4*)(qr + (size_t)row * 2048 + head * 64 + 32 + 8 * fq) = pack8(b[0], b[1]);
                }
            }
    } break;
    default: break;
    }
}

__device__ __forceinline__ const char* rfl_ptr(const void* p) { const unsigned long long v = (unsigned long long)p; const unsigned lo = __builtin_amdgcn_readfirstlane((unsigned)v), hi = __builtin_amdgcn_readfirstlane((unsigned)(v >> 32)); return (const char*)(((unsigned long long)hi << 32) | lo); }
template <bool ALIGN_EPI, bool SP2>
__device__ __forceinline__ void gemm_phase(LAS unsigned char* lds, const LAS GemmJob* g, const Sched& S) {
    const int tid = tid_opaque(), wid = __builtin_amdgcn_readfirstlane(tid >> 6), lane = tid & 63, wr = wid >> 2, wc = wid & 3, fr = lane & 15, fq = lane >> 4;
    const int K = __builtin_amdgcn_readfirstlane(g->K), nt = K / BK;
    const char* gA = rfl_ptr(g->A); const char* gB = rfl_ptr(g->Bt);
    unsigned voffA[2], voffB[2];
#pragma unroll
    for (int i = 0; i < 2; ++i) { int R, C; stage_rc(tid * 16 + i * 8192, R, C); const int Rb = (R & ~31) + perm32(R & 31);
        voffA[i] = (unsigned)(R * K + C) * 2u; voffB[i] = (unsigned)(Rb * K + C) * 2u; }
    const size_t kstep = (size_t)(BK * 2);
    const size_t hstep = (size_t)HALF * K * 2;
    const size_t tstep = 2 * hstep;
    const unsigned ldsw = (unsigned)wid * 1024u;
    const int aoff = lds_byte(wr * 64 + fr, fq * 8), boff = lds_byte(wc * 32 + fr, fq * 8);
#define PG8_SA(b, h) (((b) * 2 + (h)) * HTB)
#define PG8_SB(b, h) ((4 + (b) * 2 + (h)) * HTB)
#define PG8_STAGE(bufoff, gbase, voff) do { _Pragma("unroll") for (int _i = 0; _i < 2; ++_i) \
        __builtin_amdgcn_global_load_lds((const unsigned*)((const char*)(gbase) + (voff)[_i]), (LAS unsigned*)(lds + (bufoff) + ldsw + _i * 8192), 16, 0, 0); } while (0)
#define PG8_LDA(dst, b, h) do { _Pragma("unroll") for (int m = 0; m < 4; ++m) _Pragma("unroll") for (int k = 0; k < 2; ++k) dst[m][k] = *(const LAS bf16x8*)(lds + PG8_SA(b, h) + aoff + m * 2048 + k * 1024); } while (0)
#define PG8_LDB(dst, b, h) do { _Pragma("unroll") for (int n = 0; n < 2; ++n) _Pragma("unroll") for (int k = 0; k < 2; ++k) dst[n][k] = *(const LAS bf16x8*)(lds + PG8_SB(b, h) + boff + n * 2048 + k * 1024); } while (0)
#define PG8_MMA(ai, bj, At, Bt) do { __builtin_amdgcn_s_setprio(1); _Pragma("unroll") for (int m = 0; m < 4; ++m) _Pragma("unroll") for (int n = 0; n < 2; ++n) _Pragma("unroll") for (int k = 0; k < 2; ++k) \
        acc[ai][bj][m][n] = __builtin_amdgcn_mfma_f32_16x16x32_bf16(Bt[n][k], At[m][k], acc[ai][bj][m][n], 0, 0, 0); __builtin_amdgcn_s_setprio(0); } while (0)
#define PG8_WAIT_V(n) asm volatile("s_waitcnt vmcnt(" #n ")" ::: "memory")
#define PG8_WAIT_L(n) asm volatile("s_waitcnt lgkmcnt(" #n ")" ::: "memory")
#define PG8_BAR __builtin_amdgcn_s_barrier()
#define PG8_SCHED __builtin_amdgcn_sched_barrier(0)
    Unit cur, nxt; int ui = 0;
    if (!S.next(0, cur)) return;
    f32x4 acc[2][2][4][2];
#pragma unroll
    for (int a = 0; a < 2; ++a)
#pragma unroll
        for (int b = 0; b < 2; ++b)
#pragma unroll
            for (int m = 0; m < 4; ++m)
#pragma unroll
                for (int n = 0; n < 2; ++n) acc[a][b][m][n] = (f32x4){0.f, 0.f, 0.f, 0.f};
    bf16x8 At[4][2], B0[2][2], B1[2][2];
    const char* cA = gA + (size_t)cur.pm * tstep; const char* cB = gB + (size_t)cur.pn * tstep;
    if constexpr (SP2) {
        PG8_STAGE(PG8_SB(0, 0), cB, voffB); PG8_STAGE(PG8_SB(0, 1), cB + hstep, voffB); PG8_STAGE(PG8_SA(0, 0), cA, voffA); PG8_STAGE(PG8_SA(0, 1), cA + hstep, voffA);
        if (wr == 1) PG8_BAR;
        PG8_WAIT_V(2); PG8_BAR;
        PG8_STAGE(PG8_SB(1, 0), cB + kstep, voffB); PG8_STAGE(PG8_SA(1, 0), cA + kstep, voffA); PG8_STAGE(PG8_SB(1, 1), cB + hstep + kstep, voffB);
        PG8_WAIT_V(6); PG8_BAR;
    } else {
        PG8_STAGE(PG8_SB(0, 0), cB, voffB); PG8_STAGE(PG8_SA(0, 0), cA, voffA); PG8_STAGE(PG8_SB(0, 1), cB + hstep, voffB); PG8_STAGE(PG8_SA(0, 1), cA + hstep, voffA);
        if (wr == 1) PG8_BAR;
        PG8_WAIT_V(4); PG8_BAR;
        PG8_STAGE(PG8_SB(1, 0), cB + kstep, voffB); PG8_STAGE(PG8_SA(1, 0), cA + kstep, voffA); PG8_STAGE(PG8_SB(1, 1), cB + hstep + kstep, voffB);
        PG8_WAIT_V(6); PG8_BAR;
    }
    for (;;) {
        const bool has_next = S.next(ui + 1, nxt);
        const char* nA = has_next ? gA + (size_t)nxt.pm * tstep : cA; const char* nB = has_next ? gB + (size_t)nxt.pn * tstep : cB;
        for (int t = 0; t < nt; t += 2) {
            const bool last = (t == nt - 2);
            const char* a1 = cA + (size_t)(t + 1) * kstep;
            const char* a2 = last ? nA : cA + (size_t)(t + 2) * kstep; const char* b2 = last ? nB : cB + (size_t)(t + 2) * kstep;
            const char* a3 = a2 + kstep; const char* b3 = b2 + kstep;
            if constexpr (SP2) {
            PG8_LDB(B0, 0, 0); PG8_LDB(B1, 0, 1); PG8_SCHED; PG8_LDA(At, 0, 0); PG8_STAGE(PG8_SA(1, 1), a1 + hstep, voffA);
            PG8_WAIT_V(8); PG8_WAIT_L(0); PG8_BAR; PG8_MMA(0, 0, At, B0); PG8_MMA(0, 1, At, B1); PG8_BAR; PG8_SCHED;
            PG8_LDA(At, 0, 1); PG8_STAGE(PG8_SB(0, 0), b2, voffB); PG8_STAGE(PG8_SB(0, 1), b2 + hstep, voffB); PG8_STAGE(PG8_SA(0, 0), a2, voffA);
            PG8_WAIT_V(8); PG8_WAIT_L(0); PG8_BAR; PG8_MMA(1, 0, At, B0); PG8_MMA(1, 1, At, B1); PG8_BAR; PG8_SCHED;
            PG8_LDB(B0, 1, 0); PG8_LDB(B1, 1, 1); PG8_SCHED; PG8_LDA(At, 1, 0); PG8_STAGE(PG8_SA(0, 1), a2 + hstep, voffA);
            PG8_WAIT_V(8); PG8_WAIT_L(0); PG8_BAR; PG8_MMA(0, 0, At, B0); PG8_MMA(0, 1, At, B1); PG8_BAR; PG8_SCHED;
            PG8_LDA(At, 1, 1); PG8_STAGE(PG8_SB(1, 0), b3, voffB); PG8_STAGE(PG8_SB(1, 1), b3 + hstep, voffB); PG8_STAGE(PG8_SA(1, 0), a3, voffA);
            PG8_WAIT_V(8); PG8_WAIT_L(0); PG8_BAR; PG8_MMA(1, 0, At, B0); PG8_MMA(1, 1, At, B1); PG8_BAR; PG8_SCHED;
            } else {
            PG8_LDB(B0, 0, 0); PG8_SCHED; PG8_LDA(At, 0, 0); PG8_STAGE(PG8_SA(1, 1), a1 + hstep, voffA);
            PG8_WAIT_L(8); PG8_BAR; PG8_WAIT_L(0); PG8_MMA(0, 0, At, B0); PG8_BAR; PG8_SCHED;
            PG8_LDB(B1, 0, 1); PG8_STAGE(PG8_SB(0, 0), b2, voffB);
            PG8_BAR; PG8_WAIT_L(0); PG8_MMA(0, 1, At, B1); PG8_BAR;
            PG8_LDA(At, 0, 1); PG8_STAGE(PG8_SA(0, 0), a2, voffA);
            PG8_BAR; PG8_WAIT_L(0); PG8_MMA(1, 0, At, B0); PG8_BAR; PG8_SCHED;
            PG8_STAGE(PG8_SB(0, 1), b2 + hstep, voffB);
            PG8_WAIT_V(6); PG8_BAR; PG8_MMA(1, 1, At, B1); PG8_BAR;
            PG8_LDB(B0, 1, 0); PG8_SCHED; PG8_LDA(At, 1, 0); PG8_STAGE(PG8_SA(0, 1), a2 + hstep, voffA);
            PG8_WAIT_L(8); PG8_BAR; PG8_WAIT_L(0); PG8_MMA(0, 0, At, B0); PG8_BAR; PG8_SCHED;
            PG8_LDB(B1, 1, 1); PG8_STAGE(PG8_SB(1, 0), b3, voffB);
            PG8_BAR; PG8_WAIT_L(0); PG8_MMA(0, 1, At, B1); PG8_BAR;
            PG8_LDA(At, 1, 1); PG8_STAGE(PG8_SA(1, 0), a3, voffA);
            PG8_BAR; PG8_WAIT_L(0); PG8_MMA(1, 0, At, B0); PG8_BAR; PG8_SCHED;
            PG8_STAGE(PG8_SB(1, 1), b3 + hstep, voffB);
            PG8_WAIT_V(6); PG8_BAR; PG8_MMA(1, 1, At, B1); PG8_BAR;
            }
        }
        if constexpr (ALIGN_EPI) { if (wr == 0) PG8_BAR; }
        epilogue(acc, g, cur.pm, cur.pn, wr, wc, fr, fq);
        if (!has_next) break;
#pragma unroll
        for (int a = 0; a < 2; ++a)
#pragma unroll
            for (int b = 0; b < 2; ++b)
#pragma unroll
                for (int m = 0; m < 4; ++m)
#pragma unroll
                    for (int n = 0; n < 2; ++n) acc[a][b][m][n] = (f32x4){0.f, 0.f, 0.f, 0.f};
        cur = nxt; cA = nA; cB = nB; ++ui;
        if constexpr (ALIGN_EPI) { if (wr == 1) PG8_BAR; }
    }
    PG8_WAIT_V(0);
    if constexpr (!ALIGN_EPI) { if (wr == 0) PG8_BAR; }
    PG8_BAR;
#undef PG8_SA
#undef PG8_SB
#undef PG8_STAGE
#undef PG8_LDA
#undef PG8_LDB
#undef PG8_MMA
#undef PG8_WAIT_V
#undef PG8_WAIT_L
#undef PG8_BAR
#undef PG8_SCHED
}

struct TJob { const float* src; int ld, K, N; bf16_t* dst; const float* gain; int kind; };
__device__ __forceinline__ int wmap(int kind, int n) {
    if (kind == 0) return n;
    if (kind == 1) { const int pn = n >> 8, r = n & 255; return (r >> 7) * FF_ + pn * 128 + (r & 127); }
    if (kind == 2) { if (n < 256) return n; const int r = n - 256, half = r >> 7, rr = r & 127; return (r < 256 && rr < 32) ? 256 + half * 32 + rr : -1; }
    { if (n < 2048) return (n >> 7) * 192 + (n & 127); const int nn = n - 2048, t = nn >> 8, r = nn & 255, half = r >> 7, hl = (r & 127) >> 5, i = r & 31; return (4 * t + hl) * 192 + 128 + half * 32 + i; }
}
__device__ __forceinline__ TJob get_tjob(const KP& P, int j) {
    TJob t; unsigned char* ws = P.ws; t.gain = nullptr; t.kind = 0;
    if (j < 4) { const int l = j >> 1, jj = j & 1; t.src = P.in[4] + (size_t)j * D_ * 2 * FF_; t.ld = 2 * FF_; t.K = D_; t.N = 2 * FF_; t.dst = (bf16_t*)(ws + OFF_FI + j * SZ_FI); t.gain = P.in[3] + (l * 4 + (jj ? 2 : 0)) * D_; t.kind = 1; }
    else if (j < 8) { const int i = j - 4; t.src = P.in[5] + (size_t)i * FF_ * D_; t.ld = D_; t.K = FF_; t.N = D_; t.dst = (bf16_t*)(ws + OFF_FO + i * SZ_FO); }
    else if (j < 10) { const int l = j - 8; t.src = P.in[6] + (size_t)l * D_ * D_; t.ld = D_; t.K = D_; t.N = D_; t.dst = (bf16_t*)(ws + OFF_PG + l * 2 * MiB); t.gain = P.in[3] + (l * 4 + 3) * D_; }
    else if (j < 12) { const int l = j - 10; t.src = P.in[7] + (size_t)l * 256 * D_; t.ld = D_; t.K = 256; t.N = D_; t.dst = (bf16_t*)(ws + OFF_PI + l * (MiB / 2)); }
    else if (j == 12) { t.src = P.in[8]; t.ld = 4096; t.K = D_; t.N = 4096; t.dst = (bf16_t*)(ws + OFF_AIN); t.gain = P.in[3] + 1 * D_; }
    else if (j == 13) { t.src = P.in[11]; t.ld = D_; t.K = D_; t.N = D_; t.dst = (bf16_t*)(ws + OFF_AOUT); }
    else if (j == 14) { t.src = P.in[13]; t.ld = 320; t.K = D_; t.N = 512; t.dst = (bf16_t*)(ws + OFF_KVD); t.gain = P.in[12]; t.kind = 2; }
    else if (j == 15) { t.src = P.in[15]; t.ld = 4096; t.K = 256; t.N = 4096; t.dst = (bf16_t*)(ws + OFF_KVU); t.gain = P.in[14]; }
    else if (j == 16) { t.src = P.in[16]; t.ld = 512; t.K = D_; t.N = 512; t.dst = (bf16_t*)(ws + OFF_DQ); t.gain = P.in[3] + (4 + 1) * D_; }
    else if (j == 17) { t.src = P.in[18]; t.ld = 3072; t.K = 512; t.N = 3072; t.dst = (bf16_t*)(ws + OFF_UQ); t.gain = P.in[17]; t.kind = 3; }
    else { t.src = P.in[19]; t.ld = D_; t.K = 2048; t.N = D_; t.dst = (bf16_t*)(ws + OFF_BO); }
    return t;
}
constexpr int N_TJOBS = 19;

__device__ void prep_phase(const KP& P, LAS unsigned char* lds) {
    const int tid = tid_opaque(), wid = tid >> 6, lane = tid & 63;
    unsigned char* ws = P.ws;
    LAS bf16_t* tile = (LAS bf16_t*)lds;
    for (int j = 0; j < N_TJOBS; ++j) {
        const TJob tj = get_tjob(P, j);
        const int nkt = tj.K >> 7, ntiles = nkt * (tj.N >> 6);
        for (int t = (blockIdx.x + j * 37) % gridDim.x; t < ntiles; t += gridDim.x) {
            const int ntile = t / nkt, kt = t - ntile * nkt;
            const int nn = tid & 63, kr = tid >> 6;
            const int col = wmap(tj.kind, ntile * 64 + nn);
            float vals[16];
#pragma unroll
            for (int i = 0; i < 16; ++i) { const int k = kt * 128 + kr + 8 * i; vals[i] = (col >= 0) ? tj.src[(size_t)k * tj.ld + col] : 0.f; }
            if (tj.gain) {
#pragma unroll
                for (int i = 0; i < 16; ++i) vals[i] *= tj.gain[kt * 128 + kr + 8 * i];
            }
#pragma unroll
            for (int i = 0; i < 16; ++i) tile[nn * 136 + kr + 8 * i] = (bf16_t)(cvt_pk_bf16(vals[i], 0.f) & 0xffff);
            __syncthreads();
#pragma unroll
            for (int c2 = 0; c2 < 2; ++c2) { const int ci = tid + 512 * c2, r = ci >> 4, ch = ci & 15; const u32x4 w = *(const LAS u32x4*)(tile + r * 136 + ch * 8); *(u32x4*)(tj.dst + (size_t)(ntile * 64 + r) * tj.K + kt * 128 + ch * 8) = w; }
            __syncthreads();
        }
    }
    const int gtid = blockIdx.x * 512 + tid, gthreads = gridDim.x * 512;
    { const float* p = P.in[1]; bf16_t* pb = (bf16_t*)(ws + OFF_PB);
      for (int i = gtid; i < 2 * T_ * 256 / 4; i += gthreads) { const f32x4 v = *(const f32x4*)(p + (size_t)i * 4); u32x2 w; w.x = cvt_pk_bf16(v[0], v[1]); w.y = cvt_pk_bf16(v[2], v[3]); *(u32x2*)(pb + (size_t)i * 4) = w; } }
    { const float* x = P.in[0]; bf16_t* xb = (bf16_t*)(ws + OFF_XB); bf16_t* xlo = (bf16_t*)P.out; float* ssq = (float*)(ws + OFF_SSQ0);
      for (int row = blockIdx.x * 8 + wid; row < T_; row += gridDim.x * 8) {
          float ss = 0.f;
#pragma unroll
          for (int i = 0; i < 4; ++i) { const size_t off = (size_t)row * D_ + i * 256 + lane * 4; const f32x4 v = *(const f32x4*)(x + off); ss += (v[0] * v[0] + v[1] * v[1]) + (v[2] * v[2] + v[3] * v[3]); u32x2 w; w.x = cvt_pk_bf16(v[0], v[1]); w.y = cvt_pk_bf16(v[2], v[3]); *(u32x2*)(xb + off) = w;
              u32x2 l; l.x = cvt_pk_bf16(v[0] - bflo(w.x), v[1] - bfhi(w.x)); l.y = cvt_pk_bf16(v[2] - bflo(w.y), v[3] - bfhi(w.y)); *(u32x2*)(xlo + (size_t)row * 2048 + i * 256 + lane * 4) = l; }
#pragma unroll
          for (int o = 32; o > 0; o >>= 1) ss += __shfl_xor(ss, o);
          if (lane < 16) ssq[(size_t)row * 16 + lane] = (lane == 0) ? ss : 0.f;
      } }
    if (blockIdx.x == 0) { const float* lg = P.in[9]; float* lb = (float*)(ws + OFF_LB); for (int i = tid; i < 1024; i += 512) lb[i] = 1.0f / (1.0f + expf(lg[1024 + i] - lg[i])); }
    { const int* pos = (const int*)P.in[2]; f32x2* rope = (f32x2*)(ws + OFF_ROPE);
      for (int i = gtid; i < T_ * 32; i += gthreads) {
          const int row = i >> 5, f = i & 31;
          const float inv = P.inv_freq[f];
          const float ang = (float)pos[row] * inv;
          const double a = (double)ang; const double k = rint(a * 0.15915494309189535); double r = fma(-k, 6.283185307179586, a); r = fma(-k, 2.4492935982947064e-16, r);
          const float rf = (float)r; f32x2 cs; cs.x = cosf(rf); cs.y = sinf(rf); rope[i] = cs;
      } }
}

__device__ __forceinline__ size_t u_byte(int row0, int h, int vd) { return ((size_t)(row0 + (vd >> 1)) * D_ + h * 128) * 4 + (vd & 1) * 256; }

__device__ void hgrn_a(const KP& P, LAS unsigned char* lds) {
    unsigned char* ws = P.ws;
    bf16_t* q = (bf16_t*)(ws + OFF_HQ); float* kk = (float*)(ws + OFF_HKK); unsigned char* kkb = ws + OFF_HKK; const bf16_t* v = (const bf16_t*)(ws + OFF_HV); bf16_t* Kn = (bf16_t*)(ws + OFF_HKN); float* dec = (float*)(ws + OFF_DEC);
    LAS bf16_t* sKl = (LAS bf16_t*)lds; LAS bf16_t* sVt = (LAS bf16_t*)(lds + 18432); LAS float* tot = (LAS float*)(lds + 36864);
    const int tid = tid_opaque(), wid = tid >> 6, lane = tid & 63, fr = lane & 15, fq = lane >> 4;
    const int k = tid & 127, rg = tid >> 7;
    for (int u = blockIdx.x; u < 2048; u += gridDim.x) {
        const int bh = u >> 7, c = u & 127, b = bh >> 3, h = bh & 7;
        const int row0 = b * S_ + c * 64; const size_t base = (size_t)(row0 + rg * 16) * D_ + h * 128 + k;
        float kv[16], bb[16]; float run = 0.f; unsigned short qraw[16], vraw[16];
#pragma unroll
        for (int r = 0; r < 16; ++r) kv[r] = kk[base + (size_t)r * D_];
#pragma unroll
        for (int r = 0; r < 16; ++r) { qraw[r] = q[base + (size_t)r * D_]; vraw[r] = v[base + (size_t)r * D_]; }
#pragma unroll
        for (int r = 0; r < 16; ++r) { run += __logf(1.0f - kv[r]); bb[r] = run; }
        tot[rg * 128 + k] = run;
        __syncthreads();
        float pre = 0.f, total = 0.f;
#pragma unroll
        for (int g = 0; g < 4; ++g) { const float t = tot[g * 128 + k]; if (g < rg) pre += t; total += t; }
        unsigned klp[8], vtp[8];
#pragma unroll
        for (int r = 0; r < 16; r += 2) {
            const float b0 = bb[r] + pre, b1 = bb[r + 1] + pre;
            const float q0 = bf2f(qraw[r]) * __expf(b0), q1 = bf2f(qraw[r + 1]) * __expf(b1);
            q[base + (size_t)r * D_] = (bf16_t)(cvt_pk_bf16(q0, 0.f) & 0xffff); q[base + (size_t)(r + 1) * D_] = (bf16_t)(cvt_pk_bf16(q1, 0.f) & 0xffff);
            const float n0 = kv[r] * __expf(-b0), n1 = kv[r + 1] * __expf(-b1);
            Kn[base + (size_t)r * D_] = (bf16_t)(cvt_pk_bf16(n0, 0.f) & 0xffff); Kn[base + (size_t)(r + 1) * D_] = (bf16_t)(cvt_pk_bf16(n1, 0.f) & 0xffff);
            klp[r >> 1] = cvt_pk_bf16(kv[r] * __expf(total - b0), kv[r + 1] * __expf(total - b1));
            vtp[r >> 1] = (unsigned)vraw[r] | ((unsigned)vraw[r + 1] << 16);
        }
        *(LAS u32x4*)(sKl + k * 72 + rg * 16) = (u32x4){klp[0], klp[1], klp[2], klp[3]}; *(LAS u32x4*)(sKl + k * 72 + rg * 16 + 8) = (u32x4){klp[4], klp[5], klp[6], klp[7]};
        *(LAS u32x4*)(sVt + k * 72 + rg * 16) = (u32x4){vtp[0], vtp[1], vtp[2], vtp[3]}; *(LAS u32x4*)(sVt + k * 72 + rg * 16 + 8) = (u32x4){vtp[4], vtp[5], vtp[6], vtp[7]};
        if (rg == 0) dec[(size_t)u * 128 + k] = __expf(total);
        __syncthreads();
        const int vb = wid * 16;
        bf16x8 bfr[2];
#pragma unroll
        for (int ks = 0; ks < 2; ++ks) bfr[ks] = *(const LAS bf16x8*)(sVt + (vb + fr) * 72 + ks * 32 + fq * 8);
#pragma unroll
        for (int kb = 0; kb < 8; ++kb) {
            f32x4 a4 = (f32x4){0.f, 0.f, 0.f, 0.f};
#pragma unroll
            for (int ks = 0; ks < 2; ++ks) { const bf16x8 afr = *(const LAS bf16x8*)(sKl + (kb * 16 + fr) * 72 + ks * 32 + fq * 8); a4 = __builtin_amdgcn_mfma_f32_16x16x32_bf16(afr, bfr[ks], a4, 0, 0, 0); }
            u32x2 w; w.x = cvt_pk_bf16(a4[0], a4[1]); w.y = cvt_pk_bf16(a4[2], a4[3]);
                        *(u32x2*)(kkb + u_byte(row0, h, vb + fr) + (kb * 16 + fq * 4) * 2) = w;
        }
        __syncthreads();
    }
}

__device__ void hgrn_b(const KP& P) {
    unsigned char* ws = P.ws; unsigned char* kkb = ws + OFF_HKK; const float* dec = (const float*)(ws + OFF_DEC);
    const int tid = tid_opaque();
    for (int item = blockIdx.x * 512 + tid; item < 16 * 8192; item += gridDim.x * 512) {
        const int bh = item >> 13, e2 = item & 8191, vd = e2 >> 6, k2 = (e2 & 63) * 2, b = bh >> 3, h = bh & 7;
        float s0 = 0.f, s1 = 0.f;
        for (int c0 = 0; c0 < 128; c0 += 16) {
            unsigned uu[16]; f32x2 dd[16];
#pragma unroll
            for (int i = 0; i < 16; ++i) { const int c = c0 + i; uu[i] = *(const unsigned*)(kkb + u_byte(b * S_ + c * 64, h, vd) + k2 * 2); dd[i] = *(const f32x2*)(dec + (size_t)(bh * 128 + c) * 128 + k2); }
#pragma unroll
            for (int i = 0; i < 16; ++i) { const int c = c0 + i; *(unsigned*)(kkb + u_byte(b * S_ + c * 64, h, vd) + k2 * 2) = cvt_pk_bf16(s0, s1); s0 = dd[i].x * s0 + bflo(uu[i]); s1 = dd[i].y * s1 + bfhi(uu[i]); }
        }
    }
}

__device__ void hgrn_c(const KP& P, LAS unsigned char* lds) {
    unsigned char* ws = P.ws;
    bf16_t* q = (bf16_t*)(ws + OFF_HQ); unsigned char* kkb = ws + OFF_HKK; const bf16_t* v = (const bf16_t*)(ws + OFF_HV); const bf16_t* Kn = (const bf16_t*)(ws + OFF_HKN); const bf16_t* og = (const bf16_t*)(ws + OFF_HOG);
    const float* gain = P.in[10];
    LAS bf16_t* sQ = (LAS bf16_t*)lds; LAS bf16_t* sK = (LAS bf16_t*)(lds + 17408); LAS bf16_t* sVt = (LAS bf16_t*)(lds + 34816); LAS bf16_t* sS = (LAS bf16_t*)(lds + 53248); LAS bf16_t* sP = (LAS bf16_t*)(lds + 88064); LAS float* red = (LAS float*)(lds + 97280);
    const int tid = tid_opaque(), wid = tid >> 6, lane = tid & 63, fr = lane & 15, fq = lane >> 4;
    for (int u = blockIdx.x; u < 2048; u += gridDim.x) {
        const int bh = u >> 7, c = u & 127, b = bh >> 3, h = bh & 7; const int row0 = b * S_ + c * 64;
#pragma unroll
        for (int i = 0; i < 2; ++i) { const int ci = tid + 512 * i, r = ci >> 4, ch = ci & 15; const size_t g = (size_t)(row0 + r) * D_ + h * 128 + ch * 8;
            *(LAS u32x4*)(sQ + r * 136 + ch * 8) = *(const u32x4*)(q + g); *(LAS u32x4*)(sK + r * 136 + ch * 8) = *(const u32x4*)(Kn + g); }
#pragma unroll
        for (int i = 0; i < 4; ++i) { const int ci = tid + 512 * i, vd = ci >> 4, ch = ci & 15; *(LAS u32x4*)(sS + vd * 136 + ch * 8) = *(const u32x4*)(kkb + u_byte(row0, h, vd) + ch * 16); }
        { const int k = tid & 127, rg = tid >> 7; const size_t base = (size_t)(row0 + rg * 16) * D_ + h * 128 + k; unsigned vtp[8];
#pragma unroll
          for (int r = 0; r < 16; r += 2) vtp[r >> 1] = (unsigned)v[base + (size_t)r * D_] | ((unsigned)v[base + (size_t)(r + 1) * D_] << 16);
          *(LAS u32x4*)(sVt + k * 72 + rg * 16) = (u32x4){vtp[0], vtp[1], vtp[2], vtp[3]}; *(LAS u32x4*)(sVt + k * 72 + rg * 16 + 8) = (u32x4){vtp[4], vtp[5], vtp[6], vtp[7]}; }
        const int tb = (wid >> 1) * 16, wh = wid & 1;
        u32x2 ogw[4]; f32x4 gnv[4];
#pragma unroll
        for (int j = 0; j < 4; ++j) { const int vd0 = wh * 64 + j * 16 + 4 * fq; ogw[j] = *(const u32x2*)(og + (size_t)(row0 + tb + fr) * D_ + h * 128 + vd0); gnv[j] = *(const f32x4*)(gain + vd0); }
        __syncthreads();
        bf16x8 bq[4];
#pragma unroll
        for (int ks = 0; ks < 4; ++ks) bq[ks] = *(const LAS bf16x8*)(sQ + (tb + fr) * 136 + ks * 32 + fq * 8);
#pragma unroll
        for (int j = 0; j < 2; ++j) {
            const int sb = (wh * 2 + j) * 16; f32x4 a4 = (f32x4){0.f, 0.f, 0.f, 0.f};
#pragma unroll
            for (int ks = 0; ks < 4; ++ks) { const bf16x8 a = *(const LAS bf16x8*)(sK + (sb + fr) * 136 + ks * 32 + fq * 8); a4 = __builtin_amdgcn_mfma_f32_16x16x32_bf16(a, bq[ks], a4, 0, 0, 0); }
            const int t = tb + fr, s0 = sb + 4 * fq;
#pragma unroll
            for (int e = 0; e < 4; ++e) if (s0 + e > t) a4[e] = 0.f;
            u32x2 w; w.x = cvt_pk_bf16(a4[0], a4[1]); w.y = cvt_pk_bf16(a4[2], a4[3]);
            *(LAS u32x2*)(sP + t * 72 + s0) = w;
        }
        __syncthreads();
        bf16x8 bp[2];
#pragma unroll
        for (int ks = 0; ks < 2; ++ks) bp[ks] = *(const LAS bf16x8*)(sP + (tb + fr) * 72 + ks * 32 + fq * 8);
        f32x4 o[4]; float ss = 0.f;
#pragma unroll
        for (int j = 0; j < 4; ++j) {
            const int vb = wh * 64 + j * 16; f32x4 a4 = (f32x4){0.f, 0.f, 0.f, 0.f};
#pragma unroll
            for (int ks = 0; ks < 4; ++ks) { const bf16x8 a = *(const LAS bf16x8*)(sS + (vb + fr) * 136 + ks * 32 + fq * 8); a4 = __builtin_amdgcn_mfma_f32_16x16x32_bf16(a, bq[ks], a4, 0, 0, 0); }
#pragma unroll
            for (int ks = 0; ks < 2; ++ks) { const bf16x8 a = *(const LAS bf16x8*)(sVt + (vb + fr) * 72 + ks * 32 + fq * 8); a4 = __builtin_amdgcn_mfma_f32_16x16x32_bf16(a, bp[ks], a4, 0, 0, 0); }
            o[j] = a4; ss += (a4[0] * a4[0] + a4[1] * a4[1]) + (a4[2] * a4[2] + a4[3] * a4[3]);
        }
        ss += __shfl_xor(ss, 16); ss += __shfl_xor(ss, 32);
        if (fq == 0) red[(tb + fr) * 2 + wh] = ss;
        __syncthreads();
        const float rstd = rsqrtf((red[(tb + fr) * 2] + red[(tb + fr) * 2 + 1]) * (1.0f / 128.0f) + EPS_);
#pragma unroll
        for (int j = 0; j < 4; ++j) {
            const int vd0 = wh * 64 + j * 16 + 4 * fq; const size_t g = (size_t)(row0 + tb + fr) * D_ + h * 128 + vd0;
            const f32x4 gn = gnv[j]; const u32x2 ow = ogw[j];
            u32x2 w; w.x = cvt_pk_bf16(o[j][0] * rstd * gn[0] * bflo(ow.x), o[j][1] * rstd * gn[1] * bfhi(ow.x)); w.y = cvt_pk_bf16(o[j][2] * rstd * gn[2] * bflo(ow.y), o[j][3] * rstd * gn[3] * bfhi(ow.y));
            *(u32x2*)(q + g) = w;
        }
        __syncthreads();
    }
}

__device__ void attn_phase(const KP& P, LAS unsigned char* lds, bool dummy = false) {
    unsigned char* ws = P.ws;
    bf16_t* Qn = (bf16_t*)(ws + OFF_QNOPE); const bf16_t* Qr = (const bf16_t*)P.out + 1024; const bf16_t* Kn = (const bf16_t*)(ws + OFF_KNOPE); const bf16_t* Kr = (const bf16_t*)(ws + OFF_KROPE); const bf16_t* Vt = (const bf16_t*)(ws + OFF_VT);
    LAS unsigned char* sK = lds; LAS unsigned char* sV = lds + 25600;
    constexpr int ABUF = 44032;
    const int tid = tid_opaque(), wid = __builtin_amdgcn_readfirstlane(tid >> 6), lane = tid & 63, l32 = lane & 31, hi = lane >> 5;
    for (int u = blockIdx.x; u < 1024; u += gridDim.x) {
        const int j4 = u >> 8, cc = u & 255, xq = cc & 7, iq = cc >> 3, bh = 4 * xq + j4;
        const int qb = (j4 & 1) ? 31 - iq : iq;
        const int b = bh >> 4, h = bh & 15;
        const int q0 = qb * 256 + wid * 32; const int qi = q0 + l32; const size_t qrow = (size_t)b * S_ + qi;
        bf16x8 qf[12];
#pragma unroll
        for (int ks = 0; ks < 8; ++ks) qf[ks] = *(const bf16x8*)(Qn + qrow * 2048 + h * 128 + ks * 16 + hi * 8);
#pragma unroll
        for (int ks = 0; ks < 4; ++ks) qf[8 + ks] = *(const bf16x8*)(Qr + qrow * 2048 + h * 64 + ks * 16 + hi * 8);
        f32x16 o[4];
#pragma unroll
        for (int d = 0; d < 4; ++d)
#pragma unroll
            for (int r = 0; r < 16; ++r) o[d][r] = 0.f;
        float mrun = -INFINITY, lsum = 0.f;
        const int ntiles = qb * 4 + 4;
        const int kn_key0 = tid >> 4, kn_ch = tid & 15;
        const int kr_key = tid >> 3, kr_ch = tid & 7;
        const int v_d0 = tid >> 3, v_ch = tid & 7;
        const bf16_t* gkn = Kn + ((size_t)bh * S_ + kn_key0) * 128 + kn_ch * 8;
        const bf16_t* gkr = Kr + ((size_t)b * S_ + kr_key) * 64 + kr_ch * 8;
        const bf16_t* gv = Vt + ((size_t)bh * 128 + v_d0) * S_ + v_ch * 8;
        u32x4 pk0, pk1, pkr, pv0, pv1;
        pk0 = *(const u32x4*)(gkn); pk1 = *(const u32x4*)(gkn + 32 * 128); pkr = *(const u32x4*)(gkr); pv0 = *(const u32x4*)(gv); pv1 = *(const u32x4*)(gv + (size_t)64 * S_);
        __syncthreads();
        *(LAS u32x4*)(sK + kn_key0 * 400 + kn_ch * 16) = pk0; *(LAS u32x4*)(sK + (kn_key0 + 32) * 400 + kn_ch * 16) = pk1; *(LAS u32x4*)(sK + kr_key * 400 + 256 + kr_ch * 16) = pkr;
        *(LAS u32x4*)(sV + v_d0 * 144 + v_ch * 16) = pv0; *(LAS u32x4*)(sV + (v_d0 + 64) * 144 + v_ch * 16) = pv1;
        __syncthreads();
        for (int kt = 0; kt < ntiles; ++kt) {
            const bool more = (kt + 1 < ntiles);
            const int cur = (kt & 1) * ABUF, nxt = ABUF - cur;
            if (more) { const size_t ko = (size_t)(kt + 1) * 64;
                pk0 = *(const u32x4*)(gkn + ko * 128); pk1 = *(const u32x4*)(gkn + (ko + 32) * 128); pkr = *(const u32x4*)(gkr + ko * 64); pv0 = *(const u32x4*)(gv + ko); pv1 = *(const u32x4*)(gv + (size_t)64 * S_ + ko); }
            const int kmin = kt * 64;
            if (kmin <= q0 + 31) {
                const LAS unsigned char* cK = sK + cur; const LAS unsigned char* cV = sV + cur;
                f32x16 s0, s1;
#pragma unroll
                for (int r = 0; r < 16; ++r) { s0[r] = 0.f; s1[r] = 0.f; }
                {
                    bf16x8 A0[4], A1[4], B0[4], B1[4];
#define LDK(D0, D1, K4) _Pragma("unroll") for (int kk2 = 0; kk2 < 4; ++kk2) { D0[kk2] = *(const LAS bf16x8*)(cK + l32 * 400 + ((K4) + kk2) * 32 + hi * 16); D1[kk2] = *(const LAS bf16x8*)(cK + (32 + l32) * 400 + ((K4) + kk2) * 32 + hi * 16); }
#define MMK(D0, D1, K4) _Pragma("unroll") for (int kk2 = 0; kk2 < 4; ++kk2) { s0 = __builtin_amdgcn_mfma_f32_32x32x16_bf16(D0[kk2], qf[(K4) + kk2], s0, 0, 0, 0); s1 = __builtin_amdgcn_mfma_f32_32x32x16_bf16(D1[kk2], qf[(K4) + kk2], s1, 0, 0, 0); }
                    LDK(A0, A1, 0) LDK(B0, B1, 4)
                    MMK(A0, A1, 0)
                    LDK(A0, A1, 8)
                    MMK(B0, B1, 4)
                    MMK(A0, A1, 8)
                    __builtin_amdgcn_sched_group_barrier(0x100, 6, 0);
#pragma unroll
                    for (int gI = 0; gI < 9; ++gI) { __builtin_amdgcn_sched_group_barrier(0x008, 2, 0); __builtin_amdgcn_sched_group_barrier(0x100, 2, 0); }
                    __builtin_amdgcn_sched_group_barrier(0x008, 6, 0);
#undef LDK
#undef MMK
                }
                if (kmin + 63 > q0) {
#pragma unroll
                    for (int r = 0; r < 16; ++r) { const int key = kmin + 8 * (r >> 2) + 4 * hi + (r & 3); if (key > qi) s0[r] = -INFINITY; if (key + 32 > qi) s1[r] = -INFINITY; }
                }
                float mx = s0[0];
#pragma unroll
                for (int r = 1; r < 16; ++r) mx = fmaxf(mx, s0[r]);
#pragma unroll
                for (int r = 0; r < 16; ++r) mx = fmaxf(mx, s1[r]);
                mx = fmaxf(mx, __shfl_xor(mx, 32));
                if (__builtin_amdgcn_ballot_w64(mx > mrun + 8.0f) != 0ull) {
                    const float mnew = fmaxf(mrun, mx); const float alpha = __builtin_amdgcn_exp2f(mrun - mnew); mrun = mnew;
                    lsum *= alpha;
#pragma unroll
                    for (int d = 0; d < 4; ++d)
#pragma unroll
                        for (int r = 0; r < 16; ++r) o[d][r] *= alpha;
                }
                float ps = 0.f;
#pragma unroll
                for (int r = 0; r < 16; ++r) { s0[r] = __builtin_amdgcn_exp2f(s0[r] - mrun); s1[r] = __builtin_amdgcn_exp2f(s1[r] - mrun); ps += s0[r] + s1[r]; }
                lsum += ps;
                bf16x8 pa[2][2];
#pragma unroll
                for (int t = 0; t < 2; ++t) {
                    u32x4 w0, w1;
                    w0.x = cvt_pk_bf16(s0[8 * t + 0], s0[8 * t + 1]); w0.y = cvt_pk_bf16(s0[8 * t + 2], s0[8 * t + 3]); w0.z = cvt_pk_bf16(s0[8 * t + 4], s0[8 * t + 5]); w0.w = cvt_pk_bf16(s0[8 * t + 6], s0[8 * t + 7]);
                    w1.x = cvt_pk_bf16(s1[8 * t + 0], s1[8 * t + 1]); w1.y = cvt_pk_bf16(s1[8 * t + 2], s1[8 * t + 3]); w1.z = cvt_pk_bf16(s1[8 * t + 4], s1[8 * t + 5]); w1.w = cvt_pk_bf16(s1[8 * t + 6], s1[8 * t + 7]);
                    pa[0][t] = __builtin_bit_cast(bf16x8, w0); pa[1][t] = __builtin_bit_cast(bf16x8, w1);
                }
                {
                    u32x4 Va[4], Vb[4];
#define LDV(D, G) _Pragma("unroll") for (int d = 0; d < 4; ++d) { D[d] = *(const LAS u32x4*)(cV + (d * 32 + l32) * 144 + (((G) >> 1) * 32 + ((G) & 1) * 16 + hi * 8) * 2); }
#define MMV(D, G) _Pragma("unroll") for (int d = 0; d < 4; ++d) o[d] = __builtin_amdgcn_mfma_f32_32x32x16_bf16(__builtin_bit_cast(bf16x8, D[d]), pa[(G) >> 1][(G) & 1], o[d], 0, 0, 0);
                    LDV(Va, 0) LDV(Vb, 1)
                    MMV(Va, 0)
                    LDV(Va, 2)
                    MMV(Vb, 1)
                    LDV(Vb, 3)
                    MMV(Va, 2)
                    MMV(Vb, 3)
#undef LDV
#undef MMV
                }
            }
            if (more) {
                *(LAS u32x4*)(sK + nxt + kn_key0 * 400 + kn_ch * 16) = pk0; *(LAS u32x4*)(sK + nxt + (kn_key0 + 32) * 400 + kn_ch * 16) = pk1; *(LAS u32x4*)(sK + nxt + kr_key * 400 + 256 + kr_ch * 16) = pkr;
                *(LAS u32x4*)(sV + nxt + v_d0 * 144 + v_ch * 16) = pv0; *(LAS u32x4*)(sV + nxt + (v_d0 + 64) * 144 + v_ch * 16) = pv1;
            }
            __syncthreads();
        }
        lsum += __shfl_xor(lsum, 32);
        const float inv = 1.0f / lsum;
        bf16_t* op = Qn + qrow * 2048 + h * 128;
        if (dummy) op = (bf16_t*)(ws + WS_NEED) + ((qrow * 2048 + h * 128) & (size_t)(4 * 1024 * 1024 - 1));
#pragma unroll
        for (int d = 0; d < 4; ++d)
#pragma unroll
            for (int r4 = 0; r4 < 4; ++r4) {
                u32x2 w; w.x = cvt_pk_bf16(o[d][4 * r4] * inv, o[d][4 * r4 + 1] * inv); w.y = cvt_pk_bf16(o[d][4 * r4 + 2] * inv, o[d][4 * r4 + 3] * inv);
                *(u32x2*)(op + d * 32 + 8 * r4 + 4 * hi) = w;
            }
    }
}

__device__ void final_phase(const KP& P) {
    float* X = P.out; const float* g = P.in[20]; const bf16_t* xhi = (const bf16_t*)(P.ws + OFF_XB2); const bf16_t* xlo = (const bf16_t*)P.out;
    const int tid = tid_opaque(); const int wid = tid >> 6, lane = tid & 63;
    for (int row = blockIdx.x * 8 + wid; row < T_; row += gridDim.x * 8) {
        f32x4 v[4]; float ss = 0.f;
#pragma unroll
        for (int i = 0; i < 4; ++i) { const u32x2 h = *(const u32x2*)(xhi + (size_t)row * D_ + i * 256 + lane * 4), l = *(const u32x2*)(xlo + (size_t)row * 2048 + i * 256 + lane * 4);
            v[i] = (f32x4){bflo(h.x) + bflo(l.x), bfhi(h.x) + bfhi(l.x), bflo(h.y) + bflo(l.y), bfhi(h.y) + bfhi(l.y)}; ss += (v[i][0] * v[i][0] + v[i][1] * v[i][1]) + (v[i][2] * v[i][2] + v[i][3] * v[i][3]); }
#pragma unroll
        for (int o = 32; o > 0; o >>= 1) ss += __shfl_xor(ss, o);
        const float rs = rsqrtf(ss * (1.0f / 1024.0f) + EPS_);
#pragma unroll
        for (int i = 0; i < 4; ++i) { const f32x4 gg = *(const f32x4*)(g + i * 256 + lane * 4); *(f32x4*)(X + (size_t)row * D_ + i * 256 + lane * 4) = v[i] * rs * gg; }
    }
}

constexpr size_t OFF_BAR = OFF_LB + 65536;
__device__ __forceinline__ unsigned xcc_id() { return (unsigned)__builtin_amdgcn_s_getreg((3 << 11) | 20) & 0xFu; }
__device__ __forceinline__ void gbar(unsigned* bar, unsigned k, unsigned x, unsigned gsize, unsigned nx) {
    asm volatile("s_waitcnt vmcnt(0)" ::: "memory");
    __syncthreads();
    if (threadIdx.x == 0) {
        const unsigned old = __hip_atomic_fetch_add(bar + 64 * (16 + x), 1u, __ATOMIC_RELAXED, __HIP_MEMORY_SCOPE_AGENT);
        if (old + 1u == k * gsize) {
            __builtin_amdgcn_fence(__ATOMIC_RELEASE, "agent");
            asm volatile("s_waitcnt vmcnt(0)" ::: "memory");
            const unsigned old2 = __hip_atomic_fetch_add(bar + 64 * 32, 1u, __ATOMIC_RELAXED, __HIP_MEMORY_SCOPE_AGENT);
            if (old2 + 1u == k * nx) { for (unsigned j = 0; j < 16; ++j) __hip_atomic_store(bar + 64 * (33 + j), k, __ATOMIC_RELAXED, __HIP_MEMORY_SCOPE_AGENT); }
        }
        unsigned spins = 0;
        while (__hip_atomic_load(bar + 64 * (33 + x), __ATOMIC_RELAXED, __HIP_MEMORY_SCOPE_AGENT) < k && ++spins < (1u << 24)) __builtin_amdgcn_s_sleep(1);
        __builtin_amdgcn_fence(__ATOMIC_ACQUIRE, "agent");
        asm volatile("s_waitcnt vmcnt(0)" ::: "memory");
    }
    __syncthreads();
}
enum { PH_PREP = 0, PH_GEMM = 1, PH_HA = 2, PH_HB = 3, PH_HC = 4, PH_ATTN = 5, PH_FINAL = 6 };
constexpr int N_PHASES = 21;

__device__ __forceinline__ GemmJob mk(const void* A, const void* Bt, int N, int K, int epi, int rot) {
    GemmJob j; j.A = (const bf16_t*)A; j.Bt = (const bf16_t*)Bt; j.M = T_; j.N = N; j.K = K; j.epi = epi; j.rot = rot; j.ssq = nullptr; j.np = 16; j.invdim = 1.0f / 1024.0f;
    j.o0 = j.o1 = j.o2 = j.o3 = nullptr; j.i0 = j.i1 = nullptr; j.f0 = 1.0f; return j;
}
__device__ __forceinline__ int get_phase(const KP& P, int ph, GemmJob& j0, GemmJob& j1, int& nj) {
    unsigned char* ws = P.ws; nj = 1;
    const float* ssq0 = (const float*)(ws + OFF_SSQ0); const float* ssq1 = (const float*)(ws + OFF_SSQ1);
    auto ffn1 = [&](int l, int jj, const float* ssq) { GemmJob j = mk(ws + OFF_XB, ws + OFF_FI + (size_t)(l * 2 + jj) * SZ_FI, 2 * FF_, D_, EPI_SWIGLU, 0); j.ssq = ssq; j.o0 = ws + OFF_ACT; return j; };
    auto resid = [&](const void* A, const void* Bt, int K, float sc, size_t srchi, size_t ssqo) { GemmJob j = mk(A, Bt, D_, K, EPI_RESID, 0); j.o0 = P.out; j.o1 = ws + OFF_XB; j.o2 = ws + ssqo; j.i0 = ws + srchi; j.f0 = sc; return j; };
    auto pej = [&](int l) { GemmJob j = mk(ws + OFF_PB + (size_t)l * T_ * 256 * 2, ws + OFF_PI + (size_t)l * (MiB / 2), D_, 256, EPI_BF16, 0); j.o0 = ws + OFF_PE; return j; };
    auto plej = [&](int l) { GemmJob j = mk(ws + OFF_XB, ws + OFF_PG + (size_t)l * 2 * MiB, D_, D_, EPI_PLE, 0); j.ssq = ssq1; j.o0 = P.out; j.o1 = ws + OFF_XB2; j.o2 = ws + OFF_SSQ0; j.i0 = ws + OFF_XB; j.i1 = ws + OFF_PE; return j; };
    switch (ph) {
    case 0: return PH_PREP;
    case 1: j0 = ffn1(0, 0, ssq0); return PH_GEMM;
    case 2: j0 = resid(ws + OFF_ACT, ws + OFF_FO + 0 * SZ_FO, FF_, 0.5f, OFF_XB, OFF_SSQ1); return PH_GEMM;
    case 3: { j0 = mk(ws + OFF_XB, ws + OFF_AIN, 4096, D_, EPI_HGRN, 0); j0.ssq = ssq1; j0.o0 = ws + OFF_HQ; j0.o1 = ws + OFF_HKK; j0.o2 = ws + OFF_HV; j0.o3 = ws + OFF_HOG; j0.i0 = ws + OFF_LB; return PH_GEMM; }
    case 4: return PH_HA;
    case 5: return PH_HB;
    case 6: return PH_HC;
    case 7: j0 = resid(ws + OFF_HQ, ws + OFF_AOUT, D_, 1.0f, OFF_XB, OFF_SSQ0); return PH_GEMM;
    case 8: j0 = ffn1(0, 1, ssq0); j1 = pej(0); j1.rot = 128; nj = 2; return PH_GEMM;
    case 9: j0 = resid(ws + OFF_ACT, ws + OFF_FO + 1 * SZ_FO, FF_, 0.5f, OFF_XB, OFF_SSQ1); return PH_GEMM;
    case 10: j0 = plej(0); return PH_GEMM;
    case 11: { j0 = ffn1(1, 0, ssq0); j0.A = (const bf16_t*)(ws + OFF_XB2); j1 = mk(ws + OFF_XB2, ws + OFF_KVD, 512, D_, EPI_KVDOWN, 128); j1.ssq = ssq0; j1.o0 = ws + OFF_CKV; j1.o1 = ws + OFF_SSQCKV; j1.o2 = ws + OFF_KROPE; j1.i0 = ws + OFF_ROPE; nj = 2; return PH_GEMM; }
    case 12: j0 = resid(ws + OFF_ACT, ws + OFF_FO + 2 * SZ_FO, FF_, 0.5f, OFF_XB2, OFF_SSQ1); return PH_GEMM;
    case 13: { j0 = mk(ws + OFF_XB, ws + OFF_DQ, 512, D_, EPI_CQ, 0); j0.ssq = ssq1; j0.o0 = ws + OFF_CQ; j0.o1 = ws + OFF_SSQCQ;
               j1 = mk(ws + OFF_CKV, ws + OFF_KVU, 4096, 256, EPI_KVUP, 128); j1.ssq = (const float*)(ws + OFF_SSQCKV); j1.np = 4; j1.invdim = 1.0f / 256.0f; j1.o0 = ws + OFF_KNOPE; j1.o1 = ws + OFF_VT; nj = 2; return PH_GEMM; }
    case 14: { j0 = mk(ws + OFF_CQ, ws + OFF_UQ, 3072, 512, EPI_QUP, 0); j0.ssq = (const float*)(ws + OFF_SSQCQ); j0.np = 8; j0.invdim = 1.0f / 512.0f; j0.o0 = ws + OFF_QNOPE; j0.o1 = (bf16_t*)P.out + 1024; j0.i0 = ws + OFF_ROPE;
               j0.f0 = 0.07216878364870322f * 1.4426950408889634f; return PH_GEMM; }
    case 15: return PH_ATTN;
    case 16: j0 = resid(ws + OFF_QNOPE, ws + OFF_BO, 2048, 1.0f, OFF_XB, OFF_SSQ0); return PH_GEMM;
    case 17: j0 = ffn1(1, 1, ssq0); j1 = pej(1); j1.rot = 128; nj = 2; return PH_GEMM;
    case 18: j0 = resid(ws + OFF_ACT, ws + OFF_FO + 3 * SZ_FO, FF_, 0.5f, OFF_XB, OFF_SSQ1); return PH_GEMM;
    case 19: j0 = plej(1); return PH_GEMM;
    default: return PH_FINAL;
    }
}

constexpr int TAB_OFF = 132096, TAB_SLOT = 320;
static_assert(sizeof(GemmJob) <= 152 && TAB_OFF + N_PHASES * TAB_SLOT <= LDS_BYTES, "phase table");
__global__ void __launch_bounds__(512, 2) yoco_fwd(KP P, int ph_lo, int ph_hi) {
    extern __shared__ __attribute__((aligned(16))) unsigned char smem_raw[];
    LAS unsigned char* lds = (LAS unsigned char*)smem_raw;
    cg::grid_group grid = cg::this_grid();
    if (threadIdx.x < N_PHASES) {
        GemmJob j0 = mk(nullptr, nullptr, 256, 256, 0, 0), j1 = j0; int nj = 1;
        const int kind = get_phase(P, threadIdx.x, j0, j1, nj);
        LAS unsigned char* slot = lds + TAB_OFF + threadIdx.x * TAB_SLOT;
        *(LAS int*)slot = kind; *(LAS int*)(slot + 4) = nj;
        { const unsigned* s0 = (const unsigned*)&j0; const unsigned* s1 = (const unsigned*)&j1;
#pragma unroll
          for (int w = 0; w < (int)(sizeof(GemmJob) / 4); ++w) { *(LAS unsigned*)(slot + 16 + 4 * w) = s0[w]; *(LAS unsigned*)(slot + 16 + 152 + 4 * w) = s1[w]; } }
    }
    __syncthreads();
    if (threadIdx.x == 0) __hip_atomic_fetch_add((unsigned*)(P.ws + OFF_BAR) + 64 * xcc_id(), 1u, __ATOMIC_RELAXED, __HIP_MEMORY_SCOPE_AGENT);
    for (int ph = ph_lo; ph < ph_hi; ++ph) {
        const LAS unsigned char* slot = lds + TAB_OFF + ph * TAB_SLOT;
        const int kind = __builtin_amdgcn_readfirstlane(*(const LAS int*)slot), nj = __builtin_amdgcn_readfirstlane(*(const LAS int*)(slot + 4));
        if (kind == PH_GEMM) {
            for (int ji = 0; ji < nj; ++ji) {
                const LAS GemmJob* J = (const LAS GemmJob*)(slot + 16 + ji * 152);
                Sched S; S.init(__builtin_amdgcn_readfirstlane(J->M), __builtin_amdgcn_readfirstlane(J->N), gridDim.x, blockIdx.x, __builtin_amdgcn_readfirstlane(J->rot));
                gemm_phase<true, true>(lds, J, S);
                __syncthreads();
            }
        } else if (kind == PH_PREP) prep_phase(P, lds);
        else if (kind == PH_HA) hgrn_a(P, lds);
        else if (kind == PH_HB) hgrn_b(P);
        else if (kind == PH_HC) hgrn_c(P, lds);
        else if (kind == PH_ATTN) {
            attn_phase(P, lds);
        }
        else final_phase(P);
        if (ph + 1 < ph_hi) {
            unsigned* bar = (unsigned*)(P.ws + OFF_BAR);
            if (ph == ph_lo) {
                grid.sync();
                if (threadIdx.x == 0) { const unsigned xcc = xcc_id(); unsigned n = 0, mine = 1;
                    for (int j = 0; j < 16; ++j) { const unsigned c = __hip_atomic_load(bar + 64 * j, __ATOMIC_RELAXED, __HIP_MEMORY_SCOPE_AGENT); n += (c > 0u); if ((unsigned)j == xcc) mine = c; }
                    *(LAS unsigned*)(lds + TAB_OFF - 16) = mine; *(LAS unsigned*)(lds + TAB_OFF - 12) = n; *(LAS unsigned*)(lds + TAB_OFF - 8) = xcc; }
                __syncthreads();
            } else gbar(bar, (unsigned)(ph - ph_lo), *(LAS unsigned*)(lds + TAB_OFF - 8), *(LAS unsigned*)(lds + TAB_OFF - 16), *(LAS unsigned*)(lds + TAB_OFF - 12));
        }
    }
}

extern "C" void kernel_launch(void* const* d_in, const int* in_sizes, int n_in, void* d_out, int out_size, void* d_ws, size_t ws_size, hipStream_t stream) {
    static int grid_blocks = 0;
    if (grid_blocks == 0) {
        if (n_in != 21 || ws_size < WS_NEED) { fprintf(stderr, "kernel_launch: unexpected inputs (%d) or workspace %zu < %zu\n", n_in, ws_size, (size_t)WS_NEED); grid_blocks = -1; return; }
        int dev = 0, cus = 0, per_cu = 0;
        (void)hipGetDevice(&dev); (void)hipDeviceGetAttribute(&cus, hipDeviceAttributeMultiprocessorCount, dev);
        if (hipFuncSetAttribute((const void*)yoco_fwd, hipFuncAttributeMaxDynamicSharedMemorySize, LDS_BYTES) != hipSuccess) { fprintf(stderr, "kernel_launch: hipFuncSetAttribute failed\n"); grid_blocks = -1; return; }
        if (hipOccupancyMaxActiveBlocksPerMultiprocessor(&per_cu, (const void*)yoco_fwd, 512, LDS_BYTES) != hipSuccess || per_cu < 1) { fprintf(stderr, "kernel_launch: occupancy query says %d\n", per_cu); per_cu = 1; }
        (void)hipGetLastError();
        grid_blocks = cus * 1;
        fprintf(stderr, "kernel_launch: cus %d per_cu %d grid %d\n", cus, per_cu, grid_blocks);
    }
    if (grid_blocks < 0) return;
    KP p{};
    for (int i = 0; i < 21; ++i) p.in[i] = (const float*)d_in[i];
    p.out = (float*)d_out; p.ws = (unsigned char*)d_ws;
    for (int f = 0; f < 32; ++f) { const float ex = (float)f / 32.0f; const float pw = (float)std::pow(10000.0, (double)ex); p.inv_freq[f] = 1.0f / pw; }
    (void)hipMemsetAsync((unsigned char*)d_ws + OFF_BAR, 0, 16384, stream);
    int lo = 0, hi = N_PHASES;
    void* args[] = {&p, &lo, &hi};
    hipError_t e = hipLaunchCooperativeKernel((const void*)yoco_fwd, dim3(grid_blocks), dim3(512), args, LDS_BYTES, stream);
    if (e != hipSuccess) fprintf(stderr, "cooperative launch failed: %s (grid %d)\n", hipGetErrorString(e), grid_blocks);
}
```
